# Optimizing an MI355X kernel written in HIP

```python
import math
import jax, jax.numpy as jnp
from jax import lax
import numpy as np

D_MODEL = 1024
BATCH = 32
SEQ = 2048
DEPTH = 4
DEC_BATCH = 16
DEC_SEQ = 32
PAST_LEN = 1024

CHUNK = 64
N_HEADS = 8
HEAD_DIM = 64
D_ATT = N_HEADS * HEAD_DIM
N_PAST_CHUNKS = 8
REL_MAX = 128
N_REL = CHUNK - 1 + REL_MAX + 1
SSM_GROUP = 16
N_SSM_GROUPS = 16
D_SSM = SSM_GROUP * N_SSM_GROUPS
SSM_STATE = 64
SCONV_HEADS = 4
D_SCONV = 256
CONV_K = 3
D_MIX = D_ATT + D_SSM + D_SCONV
D_IN_PROJ = 3 * D_ATT + D_SSM + 3 * D_SCONV
SPLITS = [D_ATT, 2 * D_ATT, 3 * D_ATT, 3 * D_ATT + D_SSM,
          3 * D_ATT + D_SSM + D_SCONV, 3 * D_ATT + D_SSM + 2 * D_SCONV]
D_FF = 2048
ALPHA = (2 * DEPTH) ** 0.25
BETA = (8 * DEPTH) ** -0.25
LN_EPS = 1e-5

kernel_name = 'hybrid_streaming_encoder_step'


def layer_norm(x, g, b):
    xf = x.astype(jnp.float32)
    mu = jnp.mean(xf, axis=-1, keepdims=True)
    var = jnp.mean(jnp.square(xf - mu), axis=-1, keepdims=True)
    y = (xf - mu) * lax.rsqrt(var + LN_EPS) * g.astype(jnp.float32) + b.astype(jnp.float32)
    return y.astype(x.dtype)


def causal_dwconv(v, buf, w, bias):
    s = v.shape[1]
    vp = jnp.concatenate([buf.astype(v.dtype), v], axis=1)
    y = sum(vp[:, k:k + s] * w[k] for k in range(CONV_K)) + bias
    return y, vp[:, -(CONV_K - 1):]


def rel_index(dist):
    return jnp.clip(dist, -(CHUNK - 1), REL_MAX) + (CHUNK - 1)


def attend_block(qc, kc, vc, bias, valid):
    scores = jnp.einsum('bthd,bshd->bhts', qc, kc).astype(jnp.float32) * (HEAD_DIM ** -0.5)
    scores = scores + bias.astype(jnp.float32)[None]
    if valid is not None:
        scores = jnp.where(valid, scores, -jnp.inf)
    p = jax.nn.softmax(scores, axis=-1)
    return jnp.einsum('bhts,bshd->bthd', p.astype(vc.dtype), vc)


def chunk_attention_prompt(q, k, v, rel_bias):
    bsz, s = q.shape[:2]
    n_chunks = s // CHUNK
    pad = N_PAST_CHUNKS * CHUNK
    band = pad + CHUNK
    kp = jnp.pad(k, ((0, 0), (pad, 0), (0, 0), (0, 0)))
    vp = jnp.pad(v, ((0, 0), (pad, 0), (0, 0), (0, 0)))
    t_idx = jnp.arange(CHUNK)[:, None]
    s_idx = jnp.arange(band)[None, :]
    bias = rel_bias[:, rel_index(t_idx + pad - s_idx)]

    def one_chunk(c):
        start = c * CHUNK
        qc = lax.dynamic_slice_in_dim(q, start, CHUNK, axis=1)
        kc = lax.dynamic_slice_in_dim(kp, start, band, axis=1)
        vc = lax.dynamic_slice_in_dim(vp, start, band, axis=1)
        valid = s_idx >= pad - start
        return attend_block(qc, kc, vc, bias, valid)

    out = lax.map(one_chunk, jnp.arange(n_chunks))
    return out.transpose(1, 0, 2, 3, 4).reshape(bsz, s, D_ATT)


def chunk_attention_sample(q, k, v, k_past, v_past, rel_bias):
    bsz, t = q.shape[:2]
    n_past = k_past.shape[1]
    kc = jnp.concatenate([k_past.astype(k.dtype), k], axis=1)
    vc = jnp.concatenate([v_past.astype(v.dtype), v], axis=1)
    t_idx = jnp.arange(t)[:, None]
    s_idx = jnp.arange(n_past + t)[None, :]
    bias = rel_bias[:, rel_index(t_idx + n_past - s_idx)]
    return attend_block(q, kc, vc, bias, None).reshape(bsz, t, D_ATT)


def _scan_combine(e1, e2):
    a1, b1 = e1
    a2, b2 = e2
    return a2 * a1, a2 * b1 + b2


def s5_ssm(u, h0_re, h0_im, lam_re, lam_im, log_dt, b_re, b_im, c_re, c_im, d_skip, block):
    f32 = jnp.float32
    bsz, s, _ = u.shape
    lam = lax.complex(lam_re.astype(f32), lam_im.astype(f32))
    dt = jnp.exp(log_dt.astype(f32))[:, None]
    lbar = jnp.exp(lam * dt)
    bbar = ((lbar - 1.0) / lam)[:, :, None] * lax.complex(b_re.astype(f32), b_im.astype(f32))
    cmat = lax.complex(c_re.astype(f32), c_im.astype(f32))
    uf = u.astype(f32)
    ub = uf.reshape(bsz, s // block, block, N_SSM_GROUPS, SSM_GROUP).transpose(1, 0, 2, 3, 4)

    def step(h, u_blk):
        bu = jnp.einsum('btgc,gpc->btgp', u_blk.astype(jnp.complex64), bbar)
        bu = bu.at[:, 0].add(lbar * h)
        a = jnp.broadcast_to(lbar, bu.shape)
        _, hs = lax.associative_scan(_scan_combine, (a, bu), axis=1)
        y = jnp.einsum('btgp,gcp->btgc', hs, cmat).real
        return hs[:, -1], y

    h0 = lax.complex(h0_re.astype(f32), h0_im.astype(f32))
    h_final, ys = lax.scan(step, h0, ub)
    y = ys.transpose(1, 0, 2, 3, 4).reshape(bsz, s, D_SSM) + d_skip.astype(f32) * uf
    return y, h_final.real, h_final.imag


def trunk_layer(x, lp, past, is_prompt):
    bsz, s, _ = x.shape
    proj = jnp.einsum('bsd,de->bse', x, lp['w_in'])
    q, k, v, u, gate_b, gate_c, xv = jnp.split(proj, SPLITS, axis=-1)
    q = q.reshape(bsz, s, N_HEADS, HEAD_DIM)
    k = k.reshape(bsz, s, N_HEADS, HEAD_DIM)
    v = v.reshape(bsz, s, N_HEADS, HEAD_DIM)

    if is_prompt:
        att = chunk_attention_prompt(q, k, v, lp['rel_bias'])
        h_re0 = jnp.zeros((bsz, N_SSM_GROUPS, SSM_STATE), jnp.float32)
        h_im0 = jnp.zeros((bsz, N_SSM_GROUPS, SSM_STATE), jnp.float32)
        sconv_buf = jnp.zeros((bsz, CONV_K - 1, D_SCONV), x.dtype)
        ffn_buf = jnp.zeros((bsz, CONV_K - 1, 2 * D_FF), x.dtype)
        block = CHUNK
        keep = min(N_PAST_CHUNKS * CHUNK, s)
        new_k, new_v = k[:, s - keep:], v[:, s - keep:]
    else:
        k_past, v_past, h_re0, h_im0, sconv_buf, ffn_buf = past
        att = chunk_attention_sample(q, k, v, k_past, v_past, lp['rel_bias'])
        block = s
        new_k, new_v = k, v

    y_ssm, h_re, h_im = s5_ssm(u, h_re0, h_im0, lp['lam_re'], lp['lam_im'], lp['log_dt'],
                               lp['b_re'], lp['b_im'], lp['c_re'], lp['c_im'], lp['d'], block)
    z = jax.nn.gelu(y_ssm)
    ssm_out = (z * jax.nn.sigmoid(z @ lp['w_glu'].astype(jnp.float32))).astype(x.dtype)

    conv_out, new_sconv = causal_dwconv(gate_c * xv, sconv_buf, lp['sconv_w'], lp['sconv_b'])
    sconv_out = gate_b * conv_out

    mix = jnp.einsum('bse,ed->bsd', jnp.concatenate([att, ssm_out, sconv_out], axis=-1), lp['w_out'])
    x = layer_norm(ALPHA * x + mix, lp['ln1_g'], lp['ln1_b'])

    up = jnp.einsum('bsd,df->bsf', x, lp['w_ff_in'])
    up_c, new_ffn = causal_dwconv(up, ffn_buf, lp['ffn_conv_w'], lp['ffn_conv_b'])
    g, val = jnp.split(up_c, 2, axis=-1)
    ffn = jnp.einsum('bsf,fd->bsd', jax.nn.silu(g) * val, lp['w_ff_out'])
    x = layer_norm(ALPHA * x + ffn, lp['ln2_g'], lp['ln2_b'])
    return x, (new_k, new_v, h_re, h_im, new_sconv, new_ffn)


def setup_inputs(seed: int = 0) -> dict:
    key = jax.random.key(seed)
    keys = jax.random.split(key, 40)
    counter = [0]

    def nrm(shape, scale):
        kk = keys[counter[0]]
        counter[0] += 1
        return jax.random.normal(kk, shape, jnp.float32) * scale

    att_rows = min(N_PAST_CHUNKS * CHUNK, PAST_LEN)
    n_idx = jnp.arange(SSM_STATE, dtype=jnp.float32)
    gp = (DEPTH, N_SSM_GROUPS, SSM_STATE)
    inputs = {}
    inputs['x_prompt'] = nrm((BATCH, SEQ, D_MODEL), 1.0)
    inputs['x_sample'] = nrm((DEC_BATCH, DEC_SEQ, D_MODEL), 1.0)
    inputs['cache_k'] = nrm((DEPTH, DEC_BATCH, att_rows, N_HEADS, HEAD_DIM), 1.0)
    inputs['cache_v'] = nrm((DEPTH, DEC_BATCH, att_rows, N_HEADS, HEAD_DIM), 1.0)
    inputs['state_ssm_re'] = nrm((DEPTH, DEC_BATCH, N_SSM_GROUPS, SSM_STATE), 0.5)
    inputs['state_ssm_im'] = nrm((DEPTH, DEC_BATCH, N_SSM_GROUPS, SSM_STATE), 0.5)
    inputs['cache_sconv'] = nrm((DEPTH, DEC_BATCH, CONV_K - 1, D_SCONV), 1.0)
    inputs['cache_ffn_conv'] = nrm((DEPTH, DEC_BATCH, CONV_K - 1, 2 * D_FF), 1.0)
    inputs['ln_in_g'] = 1.0 + nrm((D_MODEL,), 0.01)
    inputs['ln_in_b'] = nrm((D_MODEL,), 0.01)
    inputs['w_in'] = nrm((DEPTH, D_MODEL, D_IN_PROJ), D_MODEL ** -0.5)
    inputs['rel_bias'] = nrm((DEPTH, N_HEADS, N_REL), 0.1)
    inputs['ssm_lam_re'] = -0.5 + nrm(gp, 0.01)
    inputs['ssm_lam_im'] = jnp.pi * n_idx + nrm(gp, 0.01)
    inputs['ssm_log_dt'] = jax.random.uniform(keys[counter[0]], (DEPTH, N_SSM_GROUPS), jnp.float32,
                                              math.log(0.001), math.log(0.1))
    counter[0] += 1
    inputs['ssm_b_re'] = nrm((DEPTH, N_SSM_GROUPS, SSM_STATE, SSM_GROUP), (2 * SSM_GROUP) ** -0.5)
    inputs['ssm_b_im'] = nrm((DEPTH, N_SSM_GROUPS, SSM_STATE, SSM_GROUP), (2 * SSM_GROUP) ** -0.5)
    inputs['ssm_c_re'] = nrm((DEPTH, N_SSM_GROUPS, SSM_GROUP, SSM_STATE), (2 * SSM_STATE) ** -0.5)
    inputs['ssm_c_im'] = nrm((DEPTH, N_SSM_GROUPS, SSM_GROUP, SSM_STATE), (2 * SSM_STATE) ** -0.5)
    inputs['ssm_d'] = nrm((DEPTH, D_SSM), 0.5)
    inputs['w_glu'] = nrm((DEPTH, D_SSM, D_SSM), D_SSM ** -0.5)
    inputs['sconv_w'] = nrm((DEPTH, CONV_K, D_SCONV), CONV_K ** -0.5)
    inputs['sconv_b'] = nrm((DEPTH, D_SCONV), 0.01)
    inputs['w_out'] = nrm((DEPTH, D_MIX, D_MODEL), BETA * D_MIX ** -0.5)
    inputs['ln1_g'] = 1.0 + nrm((DEPTH, D_MODEL), 0.01)
    inputs['ln1_b'] = nrm((DEPTH, D_MODEL), 0.01)
    inputs['w_ff_in'] = nrm((DEPTH, D_MODEL, 2 * D_FF), D_MODEL ** -0.5)
    inputs['ffn_conv_w'] = nrm((DEPTH, CONV_K, 2 * D_FF), CONV_K ** -0.5)
    inputs['ffn_conv_b'] = nrm((DEPTH, 2 * D_FF), 0.01)
    inputs['w_ff_out'] = nrm((DEPTH, D_FF, D_MODEL), BETA * D_FF ** -0.5)
    inputs['ln2_g'] = 1.0 + nrm((DEPTH, D_MODEL), 0.01)
    inputs['ln2_b'] = nrm((DEPTH, D_MODEL), 0.01)
    return inputs


def reference(x_prompt, x_sample, cache_k, cache_v, state_ssm_re, state_ssm_im, cache_sconv,
              cache_ffn_conv, ln_in_g, ln_in_b, w_in, rel_bias, ssm_lam_re, ssm_lam_im, ssm_log_dt,
              ssm_b_re, ssm_b_im, ssm_c_re, ssm_c_im, ssm_d, w_glu, sconv_w, sconv_b, w_out,
              ln1_g, ln1_b, w_ff_in, ffn_conv_w, ffn_conv_b, w_ff_out, ln2_g, ln2_b):
    xp = layer_norm(x_prompt, ln_in_g, ln_in_b)
    xs = layer_norm(x_sample, ln_in_g, ln_in_b)
    st_p = [[] for _ in range(6)]
    st_s = [[] for _ in range(6)]
    for l in range(DEPTH):
        lp = {'w_in': w_in[l], 'rel_bias': rel_bias[l], 'lam_re': ssm_lam_re[l], 'lam_im': ssm_lam_im[l],
              'log_dt': ssm_log_dt[l], 'b_re': ssm_b_re[l], 'b_im': ssm_b_im[l], 'c_re': ssm_c_re[l],
              'c_im': ssm_c_im[l], 'd': ssm_d[l], 'w_glu': w_glu[l], 'sconv_w': sconv_w[l],
              'sconv_b': sconv_b[l], 'w_out': w_out[l], 'ln1_g': ln1_g[l], 'ln1_b': ln1_b[l],
              'w_ff_in': w_ff_in[l], 'ffn_conv_w': ffn_conv_w[l], 'ffn_conv_b': ffn_conv_b[l],
              'w_ff_out': w_ff_out[l], 'ln2_g': ln2_g[l], 'ln2_b': ln2_b[l]}
        xp, new_p = trunk_layer(xp, lp, None, True)
        past = (cache_k[l], cache_v[l], state_ssm_re[l], state_ssm_im[l], cache_sconv[l], cache_ffn_conv[l])
        xs, new_s = trunk_layer(xs, lp, past, False)
        for i in range(6):
            st_p[i].append(new_p[i])
            st_s[i].append(new_s[i])
    k_p, v_p, hre_p, him_p, sc_p, ff_p = [jnp.stack(a, axis=0) for a in st_p]
    k_s, v_s, hre_s, him_s, sc_s, ff_s = [jnp.stack(a, axis=0) for a in st_s]
    return (xp, xs, k_p, v_p, k_s, v_s, hre_p, him_p, hre_s, him_s, sc_p, sc_s, ff_p, ff_s)
```

```cpp
#include <hip/hip_runtime.h>
#include <hip/hip_cooperative_groups.h>
#include <cstdio>
#include <cstdint>
namespace cg = cooperative_groups;

#ifndef SINGLE_LAUNCH
#define SINGLE_LAUNCH 1
#endif

#define LAS __attribute__((address_space(3)))
typedef unsigned short bf16_t;
typedef short bf16x8 __attribute__((ext_vector_type(8)));
typedef float f32x4 __attribute__((ext_vector_type(4)));
typedef unsigned u32x4 __attribute__((ext_vector_type(4)));
typedef unsigned u32x2 __attribute__((ext_vector_type(2)));

constexpr int MP = 65536, MS = 512, MT = MP + MS;
constexpr int DM = 1024, NPROJ = 2560, DFF2 = 4096, DFF = 2048, NL = 4;
constexpr float ALPHA = 1.681792830507429f;
constexpr float LN_EPS = 1e-5f;
constexpr float LOG2E = 1.4426950408889634f;
constexpr int NCHK = 1032;

constexpr size_t O_Y = 0;
constexpr size_t O_KP = (size_t)MT * DM;
constexpr size_t O_VP = O_KP + (size_t)NL * 32 * 512 * 512;
constexpr size_t O_KS = O_VP + (size_t)NL * 32 * 512 * 512;
constexpr size_t O_VS = O_KS + (size_t)NL * 16 * 32 * 512;
constexpr size_t O_SRP = O_VS + (size_t)NL * 16 * 32 * 512;
constexpr size_t O_SIP = O_SRP + (size_t)NL * 32 * 16 * 64;
constexpr size_t O_SRS = O_SIP + (size_t)NL * 32 * 16 * 64;
constexpr size_t O_SIS = O_SRS + (size_t)NL * 16 * 16 * 64;
constexpr size_t O_SCP = O_SIS + (size_t)NL * 16 * 16 * 64;
constexpr size_t O_SCS = O_SCP + (size_t)NL * 32 * 2 * 256;
constexpr size_t O_FFP = O_SCS + (size_t)NL * 16 * 2 * 256;
constexpr size_t O_FFS = O_FFP + (size_t)NL * 32 * 2 * 4096;
constexpr size_t O_END = O_FFS + (size_t)NL * 16 * 2 * 4096;
static_assert(O_END == 138903552, "out size");

constexpr size_t W_WIN = 1u << 20;
constexpr size_t W_WOUT = W_WIN + (size_t)NL * NPROJ * DM * 2;
constexpr size_t W_WFFI = W_WOUT + (size_t)NL * DM * DM * 2;
constexpr size_t W_WFFO = W_WFFI + (size_t)NL * DFF2 * DM * 2;
constexpr size_t W_WGLU = W_WFFO + (size_t)NL * DM * DFF * 2;
constexpr size_t W_SSMT = W_WGLU + (size_t)NL * 256 * 256 * 2;
constexpr size_t W_YK = W_SSMT + (size_t)16 * 64 * 256 * 4;
constexpr size_t W_HM = W_YK + (size_t)16 * 1024 * 1152 * 2;
constexpr size_t W_HLOC = W_HM + (size_t)16 * 256 * 1024 * 2;
constexpr size_t W_XV = W_HLOC + (size_t)4 * 16 * 1024 * 128 * 4;
constexpr size_t W_KS = W_XV + (size_t)MT * DM * 2;
constexpr size_t W_VFS = W_KS + (size_t)NL * 128 * 544 * 64 * 2;
constexpr size_t W_US = W_VFS + (size_t)NL * 128 * 18 * 2048 * 2;
constexpr size_t W_CW = W_US + (size_t)MS * 256 * 2;
constexpr size_t W_STA = W_CW + (size_t)NL * 512 * 32 * 4;
constexpr size_t W_STB = W_STA + (size_t)MT * 32;
constexpr size_t W_CS = W_STB + (size_t)MT * 32;
constexpr int CS_L = 13312;
constexpr size_t W_ONE = W_CS + (size_t)NL * CS_L * 4;
constexpr size_t W_CSP = W_ONE + 8192;
constexpr size_t W_RA = W_CSP + (size_t)NL * 16 * 2560 * 8;
constexpr size_t W_QH = W_RA;
constexpr size_t W_KH = W_QH + (size_t)8 * MT * 64 * 2;
constexpr size_t W_VF = W_KH + (size_t)8 * MT * 64 * 2;
constexpr size_t W_U2 = W_VF + (size_t)8 * NCHK * 4096 * 2;
constexpr size_t W_G = W_U2 + (size_t)16 * 1024 * 1152 * 2;
constexpr size_t W_MIX = W_G + (size_t)MT * 768 * 2;
constexpr size_t W_Z = W_MIX + (size_t)MT * DM * 2;
constexpr size_t W_RA_END1 = W_Z + (size_t)MT * 256 * 2;
constexpr size_t W_END = W_RA_END1;
static_assert(W_END < (size_t)1000 * 1024 * 1024, "ws budget");

constexpr int LDS_RED = 131072;
constexpr int LDS_RS = LDS_RED + 8192;
constexpr int LDS_BYTES = 131072 + 8192 + 2048 + 1024;

struct Params {
    const float* in[32];
    float* out;
    unsigned char* ws;
    int lo, hi;
};
typedef const Params __attribute__((address_space(4)))* CParams;
__device__ __forceinline__ CParams get_params() { CParams p = (CParams)__builtin_amdgcn_kernarg_segment_ptr(); asm volatile("" : "+s"(p)); return p; }
enum { I_XP = 0, I_XS, I_CK, I_CV, I_SRE, I_SIM, I_CSC, I_CFF, I_LNG, I_LNB, I_WIN, I_RELB, I_LAMRE, I_LAMIM, I_LOGDT,
       I_BRE, I_BIM, I_CRE, I_CIM, I_SD, I_WGLU, I_SCW, I_SCB, I_WOUT, I_LN1G, I_LN1B, I_WFFI, I_FCW, I_FCB, I_WFFO, I_LN2G, I_LN2B };

typedef float f32x2_t __attribute__((ext_vector_type(2))); typedef __bf16 bf16x2_t __attribute__((ext_vector_type(2)));
__device__ __forceinline__ unsigned cvt_pk_bf16(float lo, float hi) { f32x2_t v = {lo, hi}; bf16x2_t b = __builtin_convertvector(v, bf16x2_t); return __builtin_bit_cast(unsigned, b); }
__device__ __forceinline__ float bf_lo(unsigned w) { return __uint_as_float(w << 16); }
__device__ __forceinline__ float bf_hi(unsigned w) { return __uint_as_float(w & 0xffff0000u); }
__device__ __forceinline__ float bf1(bf16_t b) { return __uint_as_float(((unsigned)b) << 16); }
__device__ __forceinline__ bf16_t f2bf(float f) { return (bf16_t)(cvt_pk_bf16(f, 0.f) & 0xffffu); }
__device__ __forceinline__ u32x4 pack8(const f32x4 a, const f32x4 b) { u32x4 w; w.x = cvt_pk_bf16(a[0], a[1]); w.y = cvt_pk_bf16(a[2], a[3]); w.z = cvt_pk_bf16(b[0], b[1]); w.w = cvt_pk_bf16(b[2], b[3]); return w; }
__device__ __forceinline__ void unpack8(const u32x4 w, f32x4& a, f32x4& b) { a = (f32x4){bf_lo(w.x), bf_hi(w.x), bf_lo(w.y), bf_hi(w.y)}; b = (f32x4){bf_lo(w.z), bf_hi(w.z), bf_lo(w.w), bf_hi(w.w)}; }
__device__ __forceinline__ float fexp2(float x) { return __builtin_amdgcn_exp2f(x); }
__device__ __forceinline__ float frcp(float x) { return __builtin_amdgcn_rcpf(x); }
__device__ __forceinline__ float sigmoidf_(float a) { return frcp(1.f + fexp2(-LOG2E * a)); }
__device__ __forceinline__ float gelu_tanh(float y) { const float t = y + 0.044715f * y * y * y; return y * frcp(1.f + fexp2(-2.f * 0.7978845608028654f * LOG2E * t)); }
template <int CTRL> __device__ __forceinline__ float dpp_mov(float v) { return __int_as_float(__builtin_amdgcn_update_dpp(0, __float_as_int(v), CTRL, 0xF, 0xF, true)); }
__device__ __forceinline__ float xsum16(float v) { auto r = __builtin_amdgcn_permlane16_swap(__float_as_uint(v), __float_as_uint(v), false, false); return __uint_as_float(r[0]) + __uint_as_float(r[1]); }
__device__ __forceinline__ float xsum32(float v) { auto r = __builtin_amdgcn_permlane32_swap(__float_as_uint(v), __float_as_uint(v), false, false); return __uint_as_float(r[0]) + __uint_as_float(r[1]); }
__device__ __forceinline__ float xmax16(float v) { auto r = __builtin_amdgcn_permlane16_swap(__float_as_uint(v), __float_as_uint(v), false, false); return fmaxf(__uint_as_float(r[0]), __uint_as_float(r[1])); }
__device__ __forceinline__ float xmax32(float v) { auto r = __builtin_amdgcn_permlane32_swap(__float_as_uint(v), __float_as_uint(v), false, false); return fmaxf(__uint_as_float(r[0]), __uint_as_float(r[1])); }
__device__ __forceinline__ float wave_sum(float v) {
    v += dpp_mov<0xB1>(v); v += dpp_mov<0x4E>(v); v += dpp_mov<0x141>(v); v += dpp_mov<0x140>(v);
    return xsum32(xsum16(v));
}
__device__ __forceinline__ void cpow_exp(float lr, float li, float dt, float tau, float& er, float& ei) {
    const float mag = __expf(lr * dt * tau); const float th = (li * dt) * tau;
    const float k = rintf(th * 0.15915494309189535f);
    float r = fmaf(-k, 6.28318548202514648f, th); r = fmaf(-k, -1.7484555e-7f, r);
    const float rev = r * 0.15915494309189535f;
    const float s = __builtin_amdgcn_sinf(rev), c = __builtin_amdgcn_cosf(rev);
    er = mag * c; ei = mag * s;
}
__device__ __forceinline__ void ssm_cf(float lr, float li, float dt, float& cr, float& ci) {
    float er, ei; cpow_exp(lr, li, dt, 1.f, er, ei);
    const float nr = er - 1.f, ni = ei; const float den = frcp(lr * lr + li * li) ;
    cr = (nr * lr + ni * li) * den; ci = (ni * lr - nr * li) * den;
}

namespace pg8 {
constexpr int BM = 256, BK = 64, HALF = 128, HTB = HALF * BK * 2, NXCD = 8, WGM = 8;
__device__ __forceinline__ int lds_byte(int r, int c) { const int st = (r >> 4) * 2 + (c >> 5), rr = r & 15, cc = c & 31, ob = rr * 64 + cc * 2; return st * 1024 + (ob ^ (((ob >> 9) & 1) << 5)); }
__device__ __forceinline__ void stage_rc(int b, int& R, int& C) { const int st = b / 1024, sb = b % 1024, swz = sb ^ (((sb >> 9) & 1) << 5); R = (st >> 1) * 16 + swz / 64; C = (st & 1) * 32 + (swz % 64) / 2; }
__device__ __forceinline__ int perm32(int rho) { const int n = rho >> 4, i = rho & 15; return 8 * (i >> 2) + 4 * n + (i & 3); }

struct Unit { int pm, pn, bz; };
struct Gemm { const bf16_t* A; const bf16_t* Bt; int M, N, K, lda, ldb, batch; int ablk, nM1; unsigned off2; int kshift; };

struct Order {
    int nM, nN, nwg, total, G, c, rev;
    __device__ __forceinline__ void init(int M, int N, int batch, int G_, int c_) { nM = M / BM; nN = N / BM; nwg = nM * nN; total = nwg * batch; G = G_; c = c_; rev = 0; }
    __device__ __forceinline__ bool next(int i, Unit& u) const {
        const long L = (long)i * G + c; if (L >= total) return false;
        const int bz = (int)(L / nwg); int wgid = (int)(L % nwg);
        { const int q = nwg / NXCD, r = nwg % NXCD, xcd = wgid % NXCD; int off = wgid / NXCD; if (rev) off = (q + (xcd < r ? 1 : 0)) - 1 - off; wgid = (xcd < r ? xcd * (q + 1) : r * (q + 1) + (xcd - r) * q) + off; }
        const int nig = WGM * nN, gid = wgid / nig, fm = gid * WGM, gsz = (nM - fm) < WGM ? (nM - fm) : WGM;
        u.pm = fm + ((wgid % nig) % gsz); u.pn = (wgid % nig) / gsz; u.bz = bz; return true;
    }
};

template <class Epi>
__device__ __forceinline__ void gemm_phase(LAS unsigned char* lds, const Gemm g, const Order& S, const Epi& E, const int tid) {
    const int wid = __builtin_amdgcn_readfirstlane(tid >> 6), lane = tid & 63, wr = wid >> 2, wc = wid & 3, fr = lane & 15, fq = lane >> 4;
    const int nt = g.K / BK;
    unsigned voffA[2], voffB[2];
#pragma unroll
    for (int i = 0; i < 2; ++i) { int R, C; stage_rc(tid * 16 + i * 8192, R, C); const int Rb = (R & ~31) + perm32(R & 31);
        voffA[i] = (unsigned)((g.ablk * (R >> 6) + (R & 63)) * g.lda + C) * 2u; voffB[i] = (unsigned)(Rb * g.ldb + C) * 2u; }
    const size_t kstep = (size_t)(BK * 2);
    const unsigned hstepA = 2u * g.ablk * g.lda * 2u, hstepB = (unsigned)HALF * g.ldb * 2u;
    const unsigned tstepA = 2 * hstepA, tstepB = 2 * hstepB;
    const int nMb = g.M / BM, nNb = g.N / BM;
    const unsigned ldsw = (unsigned)wid * 1024u;
    const int aoff = lds_byte(wr * 64 + fr, fq * 8), boff = lds_byte(wc * 32 + fr, fq * 8);
#define PG8_SA(b, h) (((b) * 2 + (h)) * HTB)
#define PG8_SB(b, h) ((4 + (b) * 2 + (h)) * HTB)
#define PG8_STAGE(bufoff, gbase, voff) do { _Pragma("unroll") for (int _i = 0; _i < 2; ++_i) \
        __builtin_amdgcn_global_load_lds((const unsigned*)((const char*)(gbase) + (voff)[_i]), (LAS unsigned*)(lds + (bufoff) + ldsw + _i * 8192), 16, 0, 0); } while (0)
#define PG8_LDA(dst, b, h) do { _Pragma("unroll") for (int m = 0; m < 4; ++m) _Pragma("unroll") for (int k = 0; k < 2; ++k) dst[m][k] = *(const LAS bf16x8*)(lds + PG8_SA(b, h) + aoff + m * 2048 + k * 1024); } while (0)
#define PG8_LDB(dst, b, h) do { _Pragma("unroll") for (int n = 0; n < 2; ++n) _Pragma("unroll") for (int k = 0; k < 2; ++k) dst[n][k] = *(const LAS bf16x8*)(lds + PG8_SB(b, h) + boff + n * 2048 + k * 1024); } while (0)
#define PG8_MMA(ai, bj, At, Bt) do { __builtin_amdgcn_s_setprio(1); _Pragma("unroll") for (int m = 0; m < 4; ++m) _Pragma("unroll") for (int n = 0; n < 2; ++n) _Pragma("unroll") for (int k = 0; k < 2; ++k) \
        acc[ai][bj][m][n] = __builtin_amdgcn_mfma_f32_16x16x32_bf16(Bt[n][k], At[m][k], acc[ai][bj][m][n], 0, 0, 0); __builtin_amdgcn_s_setprio(0); } while (0)
#define PG8_WAIT_V(n) asm volatile("s_waitcnt vmcnt(" #n ")" ::: "memory")
#define PG8_WAIT_L(n) asm volatile("s_waitcnt lgkmcnt(" #n ")" ::: "memory")
#define PG8_BAR __builtin_amdgcn_s_barrier()
#define PG8_SCHED __builtin_amdgcn_sched_barrier(0)
    Unit cur, nxt; int ui = 0;
    if (!S.next(0, cur)) return;
    f32x4 acc[2][2][4][2];
#pragma unroll
    for (int a = 0; a < 2; ++a)
#pragma unroll
        for (int b = 0; b < 2; ++b)
#pragma unroll
            for (int m = 0; m < 4; ++m)
#pragma unroll
                for (int n = 0; n < 2; ++n) acc[a][b][m][n] = (f32x4){0.f, 0.f, 0.f, 0.f};
    bf16x8 At[4][2], B0[2][2], B1[2][2];
#define PG8_KOFF(u_) ((unsigned)(((u_).bz & ((1 << g.kshift) - 1)) * g.K) * 2u)
#define PG8_ABASE(u_) ((const char*)g.A + PG8_KOFF(u_) + ((u_).pm < g.nM1 ? (size_t)(((u_).bz >> g.kshift) * nMb + (u_).pm) * tstepA : (size_t)g.off2 + (size_t)((u_).pm - g.nM1) * tstepA))
#define PG8_BBASE(u_) ((const char*)g.Bt + PG8_KOFF(u_) + (size_t)(((u_).bz >> g.kshift) * nNb + (u_).pn) * tstepB)
    const char* cA = PG8_ABASE(cur);
    const char* cB = PG8_BBASE(cur);
    PG8_STAGE(PG8_SB(0, 0), cB, voffB); PG8_STAGE(PG8_SB(0, 1), cB + hstepB, voffB); PG8_STAGE(PG8_SA(0, 0), cA, voffA); PG8_STAGE(PG8_SA(0, 1), cA + hstepA, voffA);
    if (wr == 1) PG8_BAR;
    PG8_WAIT_V(2); PG8_BAR;
    PG8_STAGE(PG8_SB(1, 0), cB + kstep, voffB); PG8_STAGE(PG8_SA(1, 0), cA + kstep, voffA); PG8_STAGE(PG8_SB(1, 1), cB + hstepB + kstep, voffB);
    PG8_WAIT_V(6); PG8_BAR;
    for (;;) {
        const bool has_next = S.next(ui + 1, nxt);
        const char* nA = has_next ? PG8_ABASE(nxt) : cA;
        const char* nB = has_next ? PG8_BBASE(nxt) : cB;
        for (int t = 0; t < nt; t += 2) {
            const bool last = (t == nt - 2);
            const char* a1 = cA + (size_t)(t + 1) * kstep;
            const char* a2 = last ? nA : cA + (size_t)(t + 2) * kstep; const char* b2 = last ? nB : cB + (size_t)(t + 2) * kstep;
            const char* a3 = a2 + kstep; const char* b3 = b2 + kstep;
            PG8_LDB(B0, 0, 0); PG8_LDB(B1, 0, 1); PG8_SCHED; PG8_LDA(At, 0, 0); PG8_STAGE(PG8_SA(1, 1), a1 + hstepA, voffA);
            PG8_WAIT_V(8); PG8_WAIT_L(0); PG8_BAR; PG8_MMA(0, 0, At, B0); PG8_MMA(0, 1, At, B1); PG8_BAR; PG8_SCHED;
            PG8_LDA(At, 0, 1); PG8_STAGE(PG8_SB(0, 0), b2, voffB); PG8_STAGE(PG8_SB(0, 1), b2 + hstepB, voffB); PG8_STAGE(PG8_SA(0, 0), a2, voffA);
            PG8_WAIT_V(8); PG8_WAIT_L(0); PG8_BAR; PG8_MMA(1, 0, At, B0); PG8_MMA(1, 1, At, B1); PG8_BAR; PG8_SCHED;
            PG8_LDB(B0, 1, 0); PG8_LDB(B1, 1, 1); PG8_SCHED; PG8_LDA(At, 1, 0); PG8_STAGE(PG8_SA(0, 1), a2 + hstepA, voffA);
            PG8_WAIT_V(8); PG8_WAIT_L(0); PG8_BAR; PG8_MMA(0, 0, At, B0); PG8_MMA(0, 1, At, B1); PG8_BAR; PG8_SCHED;
            PG8_LDA(At, 1, 1); PG8_STAGE(PG8_SB(1, 0), b3, voffB); PG8_STAGE(PG8_SB(1, 1), b3 + hstepB, voffB); PG8_STAGE(PG8_SA(1, 0), a3, voffA);
            PG8_WAIT_V(8); PG8_WAIT_L(0); PG8_BAR; PG8_MMA(1, 0, At, B0); PG8_MMA(1, 1, At, B1); PG8_BAR; PG8_SCHED;
        }
        if (wr == 0) PG8_BAR;
        { int t2 = threadIdx.x; asm volatile("" : "+v"(t2));
          const int w2 = __builtin_amdgcn_readfirstlane(t2 >> 6), l2 = t2 & 63; E(acc, cur, w2 >> 2, w2 & 3, l2 & 15, l2 >> 4); }
        if (!has_next) break;
#pragma unroll
        for (int a = 0; a < 2; ++a)
#pragma unroll
            for (int b = 0; b < 2; ++b)
#pragma unroll
                for (int m = 0; m < 4; ++m)
#pragma unroll
                    for (int n = 0; n < 2; ++n) acc[a][b][m][n] = (f32x4){0.f, 0.f, 0.f, 0.f};
        cur = nxt; cA = nA; cB = nB; ++ui;
        if (wr == 1) PG8_BAR;
    }
    PG8_WAIT_V(0);
    PG8_BAR;
#undef PG8_ABASE
#undef PG8_KOFF
#undef PG8_BBASE
#undef PG8_SA
#undef PG8_SB
#undef PG8_STAGE
#undef PG8_LDA
#undef PG8_LDB
#undef PG8_MMA
#undef PG8_WAIT_V
#undef PG8_WAIT_L
#undef PG8_BAR
#undef PG8_SCHED
}
}

enum { EM_PROJ = 0, EM_HLOC, EM_YSSM, EM_GLU, EM_RES, EM_FFIN };
constexpr int NTP = 265, NTS = 3;
template <int CTRL> __device__ __forceinline__ float dppf(float old_, float src) { return __int_as_float(__builtin_amdgcn_update_dpp(__float_as_int(old_), __float_as_int(src), CTRL, 0xF, 0xF, false)); }
__device__ __forceinline__ float shift1(float cur, float prev) { return dppf<0x111>(dppf<0x121>(0.f, prev), cur); }
__device__ __forceinline__ float shift2(float cur, float prev) { return dppf<0x112>(dppf<0x122>(0.f, prev), cur); }
#define GST16(base, boff, val) (*(u32x4*)((unsigned char*)(base) + (unsigned)(boff)) = (val))
#define GSTF4(base, boff, val) (*(f32x4*)((unsigned char*)(base) + (unsigned)(boff)) = (val))
#define GST2(base, boff, val) (*(bf16_t*)((unsigned char*)(base) + (unsigned)(boff)) = (val))
#define GLD16(base, boff) (*(const u32x4*)((const unsigned char*)(base) + (unsigned)(boff)))
#define EPI_FENCE() asm volatile("" ::: "memory")
#define ROWSTAT(stb, row, mean_, rstd_) do { const f32x4 p0_ = *(const f32x4*)((stb) + (unsigned)(row) * 32u), p1_ = *(const f32x4*)((stb) + (unsigned)(row) * 32u + 16u); \
    mean_ = ((p0_[0] + p0_[2]) + (p1_[0] + p1_[2])) * (1.f / 1024.f); const float ex2_ = ((p0_[1] + p0_[3]) + (p1_[1] + p1_[3])) * (1.f / 1024.f); \
    rstd_ = __builtin_amdgcn_rsqf(ex2_ - mean_ * mean_ + LN_EPS); } while (0)
#define EPI_ROWSTATS_TO_LDS(stb) do { int t3_ = threadIdx.x; asm volatile("" : "+v"(t3_)); \
    if (t3_ < 256) { float mn_, rs_; ROWSTAT(stb, u.pm * 256 + t3_, mn_, rs_); LAS float* rsl_ = (LAS float*)(unsigned)LDS_RS; rsl_[2 * t3_] = mn_; rsl_[2 * t3_ + 1] = rs_; } \
    asm volatile("s_waitcnt lgkmcnt(0)" ::: "memory"); __builtin_amdgcn_s_barrier(); asm volatile("" ::: "memory"); } while (0)
#define EPI_RS(ai, m) (((const LAS float*)(unsigned)LDS_RS) + 2 * ((ai) * 128 + wr * 64 + (m) * 16 + fr_))
#define LN_CORRECT(cs_, bs_, colbase_) do { \
    _Pragma("unroll") for (int bj = 0; bj < 2; ++bj) _Pragma("unroll") for (int n = 0; n < 2; ++n) { const unsigned c4_ = (colbase_) + 128 * bj + 4 * n; \
        const f32x4 cc_ = *(const f32x4*)((cs_) + c4_), bb_ = *(const f32x4*)((bs_) + c4_); \
        _Pragma("unroll") for (int ai = 0; ai < 2; ++ai) _Pragma("unroll") for (int m = 0; m < 4; ++m) { const LAS float* rp_ = EPI_RS(ai, m); const float mn_ = rp_[0], rs_ = rp_[1]; \
            acc[ai][bj][m][n] = (acc[ai][bj][m][n] - cc_ * mn_) * rs_ + bb_; } } } while (0)
struct Epi {
    int mode, l;
    int sub;
    __device__ __forceinline__ void operator()(f32x4 (&acc)[2][2][4][2], const pg8::Unit& u, int wr, int wc, int fr, int fq) const {
#define EPI_COORDS() const CParams Pq = get_params(); float* const out = Pq->out; unsigned char* const ws = Pq->ws; (void)out; (void)ws; int fr_ = fr, fq_ = fq; asm volatile("" : "+v"(fr_), "+v"(fq_)); const unsigned rowb = (unsigned)(u.pm * 256 + wr * 64 + fr_); const unsigned colw = (unsigned)(wc * 32 + 8 * fq_); (void)rowb; (void)colw
        if (mode == EM_PROJ) {
            EPI_COORDS();
            const int pn = u.pn;
            {
                const float* cs = (const float*)(ws + W_CS) + l * CS_L;
                f32x4 cc_[2][2], bb_[2][2];
#pragma unroll
                for (int bj = 0; bj < 2; ++bj)
#pragma unroll
                    for (int n = 0; n < 2; ++n) { const unsigned c4_ = 256 * pn + colw + 128 * bj + 4 * n; cc_[bj][n] = *(const f32x4*)(cs + c4_); bb_[bj][n] = *(const f32x4*)(cs + 2560 + c4_); }
                EPI_ROWSTATS_TO_LDS(ws + W_STA);
#pragma unroll
                for (int ai = 0; ai < 2; ++ai)
#pragma unroll
                    for (int m = 0; m < 4; ++m) { const LAS float* rp_ = EPI_RS(ai, m); const float mn_ = rp_[0], rs_ = rp_[1];
#pragma unroll
                        for (int bj = 0; bj < 2; ++bj)
#pragma unroll
                            for (int n = 0; n < 2; ++n) acc[ai][bj][m][n] = (acc[ai][bj][m][n] - cc_[bj][n] * mn_) * rs_ + bb_[bj][n]; }
            }
            if (pn < 4) {
                const bool isk = pn >= 2; const unsigned pq = pn & 1;
                unsigned char* dst = ws + (isk ? W_KH : W_QH);
                const float sc = isk ? 1.f : 0.125f * LOG2E;
                const bool smp = u.pm >= 256; const bool tail = (u.pm & 7) >= 6;
                const unsigned d0 = 32 * (wc & 1) + 8 * fq_;
#pragma unroll
                for (int bj = 0; bj < 2; ++bj) {
                    const unsigned h = 4 * pq + 2 * bj + (wc >> 1);
                    const unsigned colk = 256 * pq + 128 * bj + colw;
#pragma unroll
                    for (int ai = 0; ai < 2; ++ai)
#pragma unroll
                        for (int m = 0; m < 4; ++m) {
                            const unsigned row = rowb + ai * 128 + m * 16;
                            const f32x4 v0 = acc[ai][bj][m][0], v1 = acc[ai][bj][m][1];
                            GST16(dst, ((h * MT + row) * 64 + d0) * 2, pack8(v0 * sc, v1 * sc));
                            if (isk) {
                                if (!smp) {
                                    if (tail) { const unsigned s = row & 2047, b = row >> 11; const unsigned o = (((l * 32 + b) * 512 + (s - 1536)) * 512 + colk) * 4;
                                        GSTF4(out + O_KP, o, v0); GSTF4(out + O_KP, o + 16, v1); }
                                } else {
                                    const unsigned ms = row - MP; const unsigned o = ((l * 512 + ms) * 512 + colk) * 4;
                                    GSTF4(out + O_KS, o, v0); GSTF4(out + O_KS, o + 16, v1);
                                    GST16(ws + W_KS, (((l * 128 + (ms >> 5) * 8 + h) * 544 + 512 + (ms & 31)) * 64 + d0) * 2, pack8(v0, v1));
                                }
                            }
                            EPI_FENCE();
                        }
                }
            } else if (pn < 6) {
                const unsigned pq = pn - 4;
                const bool smp = u.pm >= 256; const bool tail = (u.pm & 7) >= 6;
                const unsigned db = 2 * (wc & 1) + (fq_ >> 1), fqv = fr_ >> 2;
#pragma unroll
                for (int bj = 0; bj < 2; ++bj) {
                    const unsigned h = 4 * pq + 2 * bj + (wc >> 1);
                    const unsigned colk = 256 * pq + 128 * bj + colw;
#pragma unroll
                    for (int ai = 0; ai < 2; ++ai)
#pragma unroll
                        for (int m = 0; m < 4; ++m) {
                            const unsigned row = rowb + ai * 128 + m * 16;
                            const unsigned gc = 4 * u.pm + 2 * ai + wr, st = m >> 1, ii = (fr_ & 3) + 4 * (m & 1);
                            const f32x4 v0 = acc[ai][bj][m][0], v1 = acc[ai][bj][m][1];
                            const unsigned pb = ((((((h * NCHK + gc) * 2 + st) * 4 + db) * 64 + fqv * 16 + 8 * (fq_ & 1)) * 8) + ii) * 2;
#pragma unroll
                            for (int e = 0; e < 4; ++e) { GST2(ws + W_VF, pb + e * 16, f2bf(v0[e])); GST2(ws + W_VF, pb + (4 + e) * 16, f2bf(v1[e])); }
                            if (!smp) {
                                if (tail) { const unsigned s = row & 2047, b = row >> 11; const unsigned o = (((l * 32 + b) * 512 + (s - 1536)) * 512 + colk) * 4;
                                    GSTF4(out + O_VP, o, v0); GSTF4(out + O_VP, o + 16, v1); }
                            } else {
                                const unsigned ms = row - MP, t = ms & 31; const unsigned o = ((l * 512 + ms) * 512 + colk) * 4;
                                GSTF4(out + O_VS, o, v0); GSTF4(out + O_VS, o + 16, v1);
                                const unsigned i2 = (t & 3) + 4 * (t >> 4), fq2 = (t & 15) >> 2;
                                const unsigned ps = ((((((l * 128 + (ms >> 5) * 8 + h) * 18 + 16) * 4 + db) * 64 + fq2 * 16 + 8 * (fq_ & 1)) * 8) + i2) * 2;
#pragma unroll
                                for (int e = 0; e < 4; ++e) { GST2(ws + W_VFS, ps + e * 16, f2bf(v0[e])); GST2(ws + W_VFS, ps + (4 + e) * 16, f2bf(v1[e])); }
                            }
                            EPI_FENCE();
                        }
                }
            } else if (pn == 6) {
                const bool smp = u.pm >= 256;
#pragma unroll
                for (int bj = 0; bj < 2; ++bj) {
                    const unsigned col = 128 * bj + colw, g = col >> 4, ch0 = col & 15;
#pragma unroll
                    for (int ai = 0; ai < 2; ++ai)
#pragma unroll
                        for (int m = 0; m < 4; ++m) {
                            const unsigned row = rowb + ai * 128 + m * 16;
                            const u32x4 w = pack8(acc[ai][bj][m][0], acc[ai][bj][m][1]);
                            if (!smp) GST16(ws + W_U2, ((g * 1024 + (row >> 6)) * 1152 + (row & 63) * 16 + ch0) * 2, w);
                            else GST16(ws + W_US, ((row - MP) * 256 + col) * 2, w);
                            EPI_FENCE();
                        }
                }
            } else {
#pragma unroll
                for (int bj = 0; bj < 2; ++bj) {
                    const unsigned col = (pn - 7) * 256 + 128 * bj + colw;
#pragma unroll
                    for (int ai = 0; ai < 2; ++ai)
#pragma unroll
                        for (int m = 0; m < 4; ++m) {
                            const unsigned row = rowb + ai * 128 + m * 16;
                            GST16(ws + W_G, (row * 768 + col) * 2, pack8(acc[ai][bj][m][0], acc[ai][bj][m][1]));
                            EPI_FENCE();
                        }
                }
            }
        } else if (mode == EM_HLOC) {
            EPI_COORDS();
#pragma unroll
            for (int ai = 0; ai < 2; ++ai)
#pragma unroll
                for (int m = 0; m < 4; ++m) {
                    const unsigned row = rowb + ai * 128 + m * 16;
                    const unsigned o = (((((unsigned)u.bz & 3u) * 16u + ((unsigned)u.bz >> 2)) * 1024 + row) * 128 + colw) * 4;
                    GSTF4(ws + W_HLOC, o, acc[ai][0][m][0]); GSTF4(ws + W_HLOC, o + 16, acc[ai][0][m][1]);
                }
        } else if (mode == EM_YSSM) {
            EPI_COORDS();
            const unsigned g = u.bz;
            const float* dskip = Pq->in[I_SD] + l * 256;
#define Y_OFF(p_, q_, m_) (((g * 1024 + rowb + (p_) * 128 + (m_) * 16) * 1152 + 256 * u.pn + 128 * (q_) + colw) * 2)
            u32x4 buf[2][4];
#pragma unroll
            for (int m = 0; m < 4; ++m) buf[0][m] = GLD16(ws + W_U2, Y_OFF(0, 0, m));
#pragma unroll
            for (int bt = 0; bt < 4; ++bt) {
                const int bj = bt >> 1, ai = bt & 1;
                const unsigned col = 256 * u.pn + 128 * bj + colw, t = col >> 4, ch0 = col & 15;
                const f32x4 d0 = *(const f32x4*)(dskip + g * 16 + ch0), d1 = *(const f32x4*)(dskip + g * 16 + ch0 + 4);
                if (bt < 3) {
#pragma unroll
                    for (int m = 0; m < 4; ++m) buf[(bt + 1) & 1][m] = GLD16(ws + W_U2, Y_OFF((bt + 1) & 1, (bt + 1) >> 1, m));
                }
                EPI_FENCE();
#pragma unroll
                for (int m = 0; m < 4; ++m) {
                    const unsigned row = rowb + ai * 128 + m * 16;
                    f32x4 u0, u1; unpack8(buf[bt & 1][m], u0, u1);
                    f32x4 y0 = acc[ai][bj][m][0] + d0 * u0, y1 = acc[ai][bj][m][1] + d1 * u1;
#pragma unroll
                    for (int e = 0; e < 4; ++e) { y0[e] = gelu_tanh(y0[e]); y1[e] = gelu_tanh(y1[e]); }
                    GST16(ws + W_Z, ((row * 64 + t) * 256 + g * 16 + ch0) * 2, pack8(y0, y1));
                }
                EPI_FENCE();
            }
#undef Y_OFF
        } else if (mode == EM_GLU) {
            EPI_COORDS();
#define Z_OFF(p_, q_, m_) (((rowb + (p_) * 128 + (m_) * 16) * 256 + 128 * (q_) + colw) * 2)
            u32x4 buf[2][4];
#pragma unroll
            for (int m = 0; m < 4; ++m) buf[0][m] = GLD16(ws + W_Z, Z_OFF(0, 0, m));
#pragma unroll
            for (int bt = 0; bt < 4; ++bt) {
                const int bj = bt >> 1, ai = bt & 1;
                if (bt < 3) {
#pragma unroll
                    for (int m = 0; m < 4; ++m) buf[(bt + 1) & 1][m] = GLD16(ws + W_Z, Z_OFF((bt + 1) & 1, (bt + 1) >> 1, m));
                }
                EPI_FENCE();
#pragma unroll
                for (int m = 0; m < 4; ++m) {
                    const unsigned row = rowb + ai * 128 + m * 16;
                    f32x4 z0, z1; unpack8(buf[bt & 1][m], z0, z1);
                    f32x4 a0 = acc[ai][bj][m][0], a1 = acc[ai][bj][m][1];
#pragma unroll
                    for (int e = 0; e < 4; ++e) { a0[e] = z0[e] * sigmoidf_(a0[e]); a1[e] = z1[e] * sigmoidf_(a1[e]); }
                    GST16(ws + W_MIX, (row * 1024 + 512 + 128 * bj + colw) * 2, pack8(a0, a1));
                }
                EPI_FENCE();
            }
#undef Z_OFF
        } else if (mode == EM_RES) {
            EPI_COORDS();
#define RES_OFF(p_, q_, m_) (((rowb + (p_) * 128 + (m_) * 16) * 1024 + 256 * u.pn + 128 * (q_) + colw) * 2)
            if (sub == 0) {
                const float* gp = l ? Pq->in[I_LN2G] + (l - 1) * 1024 : (const float*)(ws + W_ONE);
                const float* bp = l ? Pq->in[I_LN2B] + (l - 1) * 1024 : (const float*)(ws + W_ONE) + 1024;
                u32x4 buf[2][4];
#pragma unroll
                for (int m = 0; m < 4; ++m) buf[0][m] = GLD16(ws + W_XV, RES_OFF(0, 0, m));
                EPI_ROWSTATS_TO_LDS(ws + W_STA);
#pragma unroll
                for (int bt = 0; bt < 4; ++bt) {
                    const int bj = bt >> 1, ai = bt & 1;
                    const unsigned col = 256 * u.pn + 128 * bj + colw;
                    const f32x4 g0 = *(const f32x4*)(gp + col), g1 = *(const f32x4*)(gp + col + 4), b0 = *(const f32x4*)(bp + col), b1 = *(const f32x4*)(bp + col + 4);
                    if (bt < 3) {
#pragma unroll
                        for (int m = 0; m < 4; ++m) buf[(bt + 1) & 1][m] = GLD16(ws + W_XV, RES_OFF((bt + 1) & 1, (bt + 1) >> 1, m));
                    }
                    EPI_FENCE();
#pragma unroll
                    for (int m = 0; m < 4; ++m) {
                        const LAS float* rp = EPI_RS(ai, m); const float mn = rp[0], rs = rp[1];
                        f32x4 x0, x1; unpack8(buf[bt & 1][m], x0, x1);
                        x0 = (x0 - mn) * rs * g0 + b0; x1 = (x1 - mn) * rs * g1 + b1;
                        GST16(ws + W_XV, RES_OFF(ai, bj, m), pack8(x0 * ALPHA + acc[ai][bj][m][0], x1 * ALPHA + acc[ai][bj][m][1]));
                    }
                    EPI_FENCE();
                }
            } else {
                LAS float* red = (LAS float*)(unsigned)LDS_RED;
                u32x4 buf[2][4]; float s1[4], s2[4];
#pragma unroll
                for (int m = 0; m < 4; ++m) buf[0][m] = GLD16(ws + W_XV, RES_OFF(0, 0, m));
#pragma unroll
                for (int bt = 0; bt < 4; ++bt) {
                    const int ai = bt >> 1, bj = bt & 1;
                    if (bt < 3) {
#pragma unroll
                        for (int m = 0; m < 4; ++m) buf[(bt + 1) & 1][m] = GLD16(ws + W_XV, RES_OFF((bt + 1) >> 1, (bt + 1) & 1, m));
                    }
                    EPI_FENCE();
#pragma unroll
                    for (int m = 0; m < 4; ++m) {
                        f32x4 x0, x1; unpack8(buf[bt & 1][m], x0, x1);
                        const u32x4 w = pack8(x0 * ALPHA + acc[ai][bj][m][0], x1 * ALPHA + acc[ai][bj][m][1]);
                        GST16(ws + W_XV, RES_OFF(ai, bj, m), w);
                        f32x4 r0, r1; unpack8(w, r0, r1);
                        const float a = ((r0[0] + r0[1]) + (r0[2] + r0[3])) + ((r1[0] + r1[1]) + (r1[2] + r1[3]));
                        const float b = ((r0[0] * r0[0] + r0[1] * r0[1]) + (r0[2] * r0[2] + r0[3] * r0[3])) + ((r1[0] * r1[0] + r1[1] * r1[1]) + (r1[2] * r1[2] + r1[3] * r1[3]));
                        if (bj == 0) { s1[m] = a; s2[m] = b; } else { s1[m] += a; s2[m] += b; }
                    }
                    if (bj == 1) {
#pragma unroll
                        for (int m = 0; m < 4; ++m) {
                            float a = s1[m], b = s2[m];
                            a = xsum32(xsum16(a)); b = xsum32(xsum16(b));
                            if (fq_ == 0) { const int ri = wc * 256 + ai * 128 + wr * 64 + m * 16 + fr_; red[2 * ri] = a; red[2 * ri + 1] = b; }
                        }
                    }
                    EPI_FENCE();
                }
                asm volatile("s_waitcnt lgkmcnt(0)" ::: "memory"); __builtin_amdgcn_s_barrier(); asm volatile("" ::: "memory");
                { int t3 = threadIdx.x; asm volatile("" : "+v"(t3));
                  if (t3 < 256) { float a = 0.f, b = 0.f;
#pragma unroll
                      for (int q = 0; q < 4; ++q) { a += red[2 * (q * 256 + t3)]; b += red[2 * (q * 256 + t3) + 1]; }
                      typedef float f32x2v __attribute__((ext_vector_type(2)));
                      *(f32x2v*)(ws + W_STA + ((unsigned)(u.pm * 256 + t3) * 4u + u.pn) * 8u) = (f32x2v){a, b}; } }
            }
#undef RES_OFF
        } else {
            EPI_COORDS();
            const bool smp = u.pm >= NTP;
            const int R0t = smp ? (MP + 248 * (u.pm - NTP) - 2) : (248 * u.pm - 2);
            const int lim = smp ? MT : MP;
            const float* cachef = Pq->in[I_CFF];
            {
                int t3_ = threadIdx.x; asm volatile("" : "+v"(t3_));
                if (t3_ < 256) *(LAS f32x4*)(unsigned)(LDS_RED + t3_ * 16) = *(const f32x4*)(ws + W_CW + (unsigned)((l * 512 + 32 * u.pn) * 128 + t3_ * 16));
                asm volatile("s_waitcnt vmcnt(0) lgkmcnt(0)" ::: "memory"); __builtin_amdgcn_s_barrier(); asm volatile("" ::: "memory");
            }
#pragma unroll
            for (int n = 0; n < 2; ++n) {
                EPI_FENCE();
                const unsigned f0 = 128 * u.pn + colw + 4 * n;
                const LAS f32x4* cwp = (const LAS f32x4*)(unsigned)(LDS_RED + (8 * wc + 2 * fq_ + n) * 128);
                const f32x4 wg0 = cwp[0], wg1 = cwp[1], wg2 = cwp[2], wv0 = cwp[3], wv1 = cwp[4], wv2 = cwp[5], bg = cwp[6], bv = cwp[7];
#pragma unroll
                for (int ai = 0; ai < 2; ++ai) {
                    const int Rb = R0t + 62 * (2 * ai + wr);
#pragma unroll
                    for (int m = 0; m < 4; ++m) {
                        const int w = 16 * m + fr_, R = Rb + w;
                        const f32x4 g0 = acc[ai][0][m][n], v0 = acc[ai][1][m][n];
                        const f32x4 gp = acc[ai][0][m ? m - 1 : 0][n], vp = acc[ai][1][m ? m - 1 : 0][n];
                        f32x4 g1, g2, v1, v2;
#pragma unroll
                        for (int e = 0; e < 4; ++e) { g1[e] = shift1(g0[e], gp[e]); g2[e] = shift2(g0[e], gp[e]); v1[e] = shift1(v0[e], vp[e]); v2[e] = shift2(v0[e], vp[e]); }
                        const bool ok = (w >= 2) && (R < lim);
                        if (!smp) {
                            const int sq = R & 2047;
                            if (sq == 0) { g1 = (f32x4){0.f, 0.f, 0.f, 0.f}; v1 = g1; }
                            if (sq <= 1) { g2 = (f32x4){0.f, 0.f, 0.f, 0.f}; v2 = g2; }
                        } else if (ok) {
                            const int t = (R - MP) & 31, b = (R - MP) >> 5;
                            if (t <= 1) {
                                const float* c1 = cachef + ((size_t)(l * 16 + b) * 2 + 1) * 4096 + f0;
                                const f32x4 cg = *(const f32x4*)c1, cv = *(const f32x4*)(c1 + 2048);
                                if (t == 0) { g1 = cg; v1 = cv; g2 = *(const f32x4*)(c1 - 4096); v2 = *(const f32x4*)(c1 - 4096 + 2048); }
                                else { g2 = cg; v2 = cv; }
                            }
                        }
                        const f32x4 gg = wg0 * g2 + wg1 * g1 + wg2 * g0 + bg, vv = wv0 * v2 + wv1 * v1 + wv2 * v0 + bv;
                        f32x4 h;
#pragma unroll
                        for (int e = 0; e < 4; ++e) h[e] = gg[e] * sigmoidf_(gg[e]) * vv[e];
                        if (ok) {
                            u32x2 hw; hw.x = cvt_pk_bf16(h[0], h[1]); hw.y = cvt_pk_bf16(h[2], h[3]);
                            *(u32x2*)((unsigned char*)out + ((unsigned)R * 2048u + f0) * 2u) = hw;
                            if (!smp) {
                                const int sq = R & 2047;
                                if (sq >= 2046) { const unsigned o = (((l * 32 + (R >> 11)) * 2 + (sq - 2046)) * 4096 + f0) * 4; GSTF4(out + O_FFP, o, g0); GSTF4(out + O_FFP, o + 8192, v0); }
                            } else {
                                const int t = (R - MP) & 31, b = (R - MP) >> 5;
                                if (t >= 30) { const unsigned o = (((l * 16 + b) * 2 + (t - 30)) * 4096 + f0) * 4; GSTF4(out + O_FFS, o, g0); GSTF4(out + O_FFS, o + 8192, v0); }
                            }
                        }
                        EPI_FENCE();
                    }
                }
            }
        }
    }
};

struct Ctx { int tid, lane, wave, G, bid, gtid, NT, gw, NGW; };

__device__ __forceinline__ int ffperm(int n) { return n < 2048 ? ((n >> 7) << 8) + (n & 127) : (((n - 2048) >> 7) << 8) + 128 + ((n - 2048) & 127); }
__device__ __forceinline__ void transpose_item(const float* W, int K, int N, bf16_t* WT, LAS float* scr, int item, int lane, bool ffp = false, const float* gk = nullptr) {
    const int nblk = N / 32, kb = item / nblk, nb = item % nblk, k0 = 64 * kb, n0 = 32 * nb;
#pragma unroll 8
    for (int i = 0; i < 32; ++i) { const int kk = 2 * i + (lane >> 5); float wv = W[(size_t)(k0 + kk) * N + n0 + (lane & 31)]; if (gk) wv *= gk[k0 + kk]; scr[kk * 33 + (lane & 31)] = wv; }
    asm volatile("s_waitcnt lgkmcnt(0)" ::: "memory");
    const int c = lane & 7;
#pragma unroll
    for (int j = 0; j < 4; ++j) { const int n = (lane >> 3) + 8 * j; const LAS float* s = scr + (8 * c) * 33 + n;
        u32x4 o; o.x = cvt_pk_bf16(s[0 * 33], s[1 * 33]); o.y = cvt_pk_bf16(s[2 * 33], s[3 * 33]); o.z = cvt_pk_bf16(s[4 * 33], s[5 * 33]); o.w = cvt_pk_bf16(s[6 * 33], s[7 * 33]);
        const int nd = ffp ? ffperm(n0 + n) : (n0 + n);
        *(u32x4*)(WT + (size_t)nd * K + k0 + 8 * c) = o; }
    asm volatile("s_waitcnt lgkmcnt(0)" ::: "memory");
}

__device__ __forceinline__ void ln_in_load(const float* xrow, f32x4 (&v)[4], int lane) {
#pragma unroll
    for (int j = 0; j < 2; ++j) { v[2 * j] = *(const f32x4*)(xrow + lane * 8 + 512 * j); v[2 * j + 1] = *(const f32x4*)(xrow + lane * 8 + 512 * j + 4); }
}
__device__ __forceinline__ void ln_in_compute(f32x4 (&v)[4], const float* g, const float* b, bf16_t* orow, int lane) {
    float s = 0.f;
#pragma unroll
    for (int j = 0; j < 4; ++j) s += (v[j][0] + v[j][1]) + (v[j][2] + v[j][3]);
    const float mean = wave_sum(s) * (1.f / 1024.f); float q = 0.f;
#pragma unroll
    for (int j = 0; j < 4; ++j) { v[j] = v[j] - mean; q += (v[j][0] * v[j][0] + v[j][1] * v[j][1]) + (v[j][2] * v[j][2] + v[j][3] * v[j][3]); }
    const float rstd = 1.f / sqrtf(wave_sum(q) * (1.f / 1024.f) + LN_EPS);
#pragma unroll
    for (int j = 0; j < 2; ++j) {
        const int c = lane * 8 + 512 * j;
        const f32x4 g0 = *(const f32x4*)(g + c), g1 = *(const f32x4*)(g + c + 4), b0 = *(const f32x4*)(b + c), b1 = *(const f32x4*)(b + c + 4);
        *(u32x4*)(orow + c) = pack8(v[2 * j] * rstd * g0 + b0, v[2 * j + 1] * rstd * g1 + b1);
    }
}

__device__ __forceinline__ void ln_phase(const Ctx& C, unsigned char* ws, const float* g, const float* b, float* yout) {
    bf16_t* xv = (bf16_t*)(ws + W_XV);
    f32x4 gg[4], bb[4];
#pragma unroll
    for (int j = 0; j < 2; ++j) { const int c = C.lane * 8 + 512 * j; gg[2 * j] = *(const f32x4*)(g + c); gg[2 * j + 1] = *(const f32x4*)(g + c + 4); bb[2 * j] = *(const f32x4*)(b + c); bb[2 * j + 1] = *(const f32x4*)(b + c + 4); }
    for (int row0 = C.gw; row0 < MT; row0 += 4 * C.NGW) {
        u32x4 w[4][2];
#pragma unroll
        for (int k = 0; k < 4; ++k) { const int row = row0 + k * C.NGW;
            if (row < MT) {
#pragma unroll
                for (int j = 0; j < 2; ++j) w[k][j] = *(const u32x4*)(xv + (size_t)row * 1024 + C.lane * 8 + 512 * j);
            } else { w[k][0] = (u32x4){0u, 0u, 0u, 0u}; w[k][1] = w[k][0]; } }
#pragma unroll
        for (int k = 0; k < 4; ++k) { const int row = row0 + k * C.NGW;
            if (row < MT) {
                bf16_t* xr = xv + (size_t)row * 1024;
                f32x4 v[4]; float s = 0.f;
#pragma unroll
                for (int j = 0; j < 2; ++j) unpack8(w[k][j], v[2 * j], v[2 * j + 1]);
#pragma unroll
                for (int j = 0; j < 4; ++j) s += (v[j][0] + v[j][1]) + (v[j][2] + v[j][3]);
                const float mean = wave_sum(s) * (1.f / 1024.f); float q = 0.f;
#pragma unroll
                for (int j = 0; j < 4; ++j) { v[j] = v[j] - mean; q += (v[j][0] * v[j][0] + v[j][1] * v[j][1]) + (v[j][2] * v[j][2] + v[j][3] * v[j][3]); }
                const float rstd = 1.f / sqrtf(wave_sum(q) * (1.f / 1024.f) + LN_EPS);
#pragma unroll
                for (int j = 0; j < 4; ++j) v[j] = v[j] * rstd * gg[j] + bb[j];
#pragma unroll
                for (int j = 0; j < 2; ++j) *(u32x4*)(xr + C.lane * 8 + 512 * j) = pack8(v[2 * j], v[2 * j + 1]);
                if (yout) {
#pragma unroll
                    for (int j = 0; j < 2; ++j) { float* p = yout + (size_t)row * 1024 + C.lane * 8 + 512 * j; *(f32x4*)p = v[2 * j]; *(f32x4*)(p + 4) = v[2 * j + 1]; }
                }
            } }
    }
}

__device__ __forceinline__ void ssm_T_phase(const Ctx& C, int l, LAS unsigned char* lds) {
    const CParams Pp = get_params();
    LAS float* Wr = (LAS float*)lds; LAS float* Wi = Wr + 64 * 17;
    float* T = (float*)(Pp->ws + W_SSMT);
    for (int unit = C.bid; unit < 1024; unit += C.G) {
        const int g = unit >> 6, tau = unit & 63;
        const int p = C.tid >> 3, c2 = (C.tid & 7) * 2;
        const float lr = Pp->in[I_LAMRE][(l * 16 + g) * 64 + p], li = Pp->in[I_LAMIM][(l * 16 + g) * 64 + p], dt = __expf(Pp->in[I_LOGDT][l * 16 + g]);
        float er, ei, cr, ci; cpow_exp(lr, li, dt, (float)tau, er, ei); ssm_cf(lr, li, dt, cr, ci);
        const float fr_ = er * cr - ei * ci, fi_ = er * ci + ei * cr;
#pragma unroll
        for (int k = 0; k < 2; ++k) {
            const size_t bi = ((size_t)(l * 16 + g) * 64 + p) * 16 + c2 + k;
            const float br = Pp->in[I_BRE][bi], bim = Pp->in[I_BIM][bi];
            Wr[p * 17 + c2 + k] = fr_ * br - fi_ * bim; Wi[p * 17 + c2 + k] = fr_ * bim + fi_ * br;
        }
        __syncthreads();
        if (C.tid < 256) {
            const int co = C.tid >> 4, ci2 = C.tid & 15;
            const float* cre = Pp->in[I_CRE] + ((size_t)(l * 16 + g) * 16 + co) * 64; const float* cim = Pp->in[I_CIM] + ((size_t)(l * 16 + g) * 16 + co) * 64;
            float a = 0.f;
            for (int pp = 0; pp < 64; ++pp) a += cre[pp] * Wr[pp * 17 + ci2] - cim[pp] * Wi[pp * 17 + ci2];
            T[((size_t)(g * 64 + tau) * 16 + co) * 16 + ci2] = a;
        }
        __syncthreads();
    }
}

__device__ __forceinline__ void ssm_fill_phase(const Ctx& C, int l) {
    const CParams Pp = get_params();
    const float* T = (const float*)(Pp->ws + W_SSMT);
    bf16_t* YK = (bf16_t*)(Pp->ws + W_YK); bf16_t* HM = (bf16_t*)(Pp->ws + W_HM);
    for (int item = C.gtid; item < 16 * 1024 * 128; item += C.NT) {
        const int half = item & 1, s = (item >> 1) & 63, rowi = item >> 7, g = rowi >> 10, t = (rowi >> 4) & 63, co = rowi & 15;
        u32x4 w = (u32x4){0u, 0u, 0u, 0u};
        if (s <= t) { const float* tp = T + ((size_t)(g * 64 + (t - s)) * 16 + co) * 16 + half * 8; w = pack8(*(const f32x4*)tp, *(const f32x4*)(tp + 4)); }
        *(u32x4*)(YK + (size_t)rowi * 1152 + s * 16 + half * 8) = w;
    }
    for (int item = C.gtid; item < 16 * 1024 * 64; item += C.NT) {
        const int p = item & 63, rowi = item >> 6, g = rowi >> 10, t = (rowi >> 4) & 63, co = rowi & 15;
        const float lr = Pp->in[I_LAMRE][(l * 16 + g) * 64 + p], li = Pp->in[I_LAMIM][(l * 16 + g) * 64 + p], dt = __expf(Pp->in[I_LOGDT][l * 16 + g]);
        float er, ei; cpow_exp(lr, li, dt, (float)(t + 1), er, ei);
        const size_t ci_ = ((size_t)(l * 16 + g) * 16 + co) * 64 + p;
        const float cr = Pp->in[I_CRE][ci_], ci = Pp->in[I_CIM][ci_];
        YK[(size_t)rowi * 1152 + 1024 + p] = f2bf(cr * er - ci * ei);
        YK[(size_t)rowi * 1152 + 1088 + p] = f2bf(-(cr * ei + ci * er));
    }
    for (int item = C.gtid; item < 16 * 128 * 64; item += C.NT) {
        const int s = item & 63, pr = (item >> 6) & 127, g = item >> 13, p = pr & 63, part = pr >> 6;
        const float lr = Pp->in[I_LAMRE][(l * 16 + g) * 64 + p], li = Pp->in[I_LAMIM][(l * 16 + g) * 64 + p], dt = __expf(Pp->in[I_LOGDT][l * 16 + g]);
        float er, ei, cr, ci; cpow_exp(lr, li, dt, (float)(63 - s), er, ei); ssm_cf(lr, li, dt, cr, ci);
        const float fr_ = er * cr - ei * ci, fi_ = er * ci + ei * cr;
        const float* br = Pp->in[I_BRE] + ((size_t)(l * 16 + g) * 64 + p) * 16; const float* bi = Pp->in[I_BIM] + ((size_t)(l * 16 + g) * 64 + p) * 16;
        f32x4 o[4];
#pragma unroll
        for (int q = 0; q < 4; ++q) {
            const f32x4 b_r = *(const f32x4*)(br + 4 * q), b_i = *(const f32x4*)(bi + 4 * q);
            o[q] = part ? (b_i * fr_ + b_r * fi_) : (b_r * fr_ - b_i * fi_);
        }
        bf16_t* dst = HM + ((size_t)g * 256 + pr) * 1024 + s * 16;
        *(u32x4*)dst = pack8(o[0], o[1]); *(u32x4*)(dst + 8) = pack8(o[2], o[3]);
    }
    for (int item = C.gtid; item < 16 * 128 * 128; item += C.NT) {
        const int c8 = item & 127, r = (item >> 7) & 127, g = item >> 14;
        *(u32x4*)(HM + ((size_t)g * 256 + 128 + r) * 1024 + c8 * 8) = (u32x4){0u, 0u, 0u, 0u};
    }
}

__device__ __forceinline__ void convert_layer(const Ctx& C, LAS unsigned char* lds, int l) {
    const CParams Pp = get_params();
    LAS float* scr = (LAS float*)(lds + C.wave * 16384);
    constexpr int I_A = 16 * 80, I_B = 16 * 32, I_C = 16 * 128, I_D = 32 * 32, I_E = 4 * 8, I_L = I_A + I_B + I_C + I_D + I_E;
    for (int it = C.gw; it < I_L; it += C.NGW) {
        int r = it;
        if (r < I_A) { transpose_item(Pp->in[I_WIN] + (size_t)l * DM * NPROJ, DM, NPROJ, (bf16_t*)(Pp->ws + W_WIN) + (size_t)l * NPROJ * DM, scr, r, C.lane, false, l ? Pp->in[I_LN2G] + (l - 1) * 1024 : nullptr); continue; } r -= I_A;
        if (r < I_B) { transpose_item(Pp->in[I_WOUT] + (size_t)l * DM * DM, DM, DM, (bf16_t*)(Pp->ws + W_WOUT) + (size_t)l * DM * DM, scr, r, C.lane); continue; } r -= I_B;
        if (r < I_C) { transpose_item(Pp->in[I_WFFI] + (size_t)l * DM * DFF2, DM, DFF2, (bf16_t*)(Pp->ws + W_WFFI) + (size_t)l * DFF2 * DM, scr, r, C.lane, true); continue; } r -= I_C;
        if (r < I_D) { transpose_item(Pp->in[I_WFFO] + (size_t)l * DFF * DM, DFF, DM, (bf16_t*)(Pp->ws + W_WFFO) + (size_t)l * DM * DFF, scr, r, C.lane); continue; } r -= I_D;
        transpose_item(Pp->in[I_WGLU] + (size_t)l * 65536, 256, 256, (bf16_t*)(Pp->ws + W_WGLU) + (size_t)l * 65536, scr, r, C.lane);
    }
    for (int item = C.gtid; item < 16 * 512 * 8 * 8; item += C.NT) {
        const int d8 = item & 7, h = (item >> 3) & 7, j = (item >> 6) & 511, b = (item >> 15) & 15;
        const float* src = Pp->in[I_CK] + ((((size_t)(l * 16 + b) * 512 + j) * 8 + h) * 64 + d8 * 8);
        *(u32x4*)((bf16_t*)(Pp->ws + W_KS) + ((size_t)(l * 128 + b * 8 + h) * 544 + j) * 64 + d8 * 8) = pack8(*(const f32x4*)src, *(const f32x4*)(src + 4));
    }
    for (int item = C.gtid; item < 128 * 16 * 4 * 64; item += C.NT) {
        const int ln = item & 63, db = (item >> 6) & 3, st = (item >> 8) & 15, bh = (item >> 12) & 127;
        const int frv = ln & 15, fqv = ln >> 4, d = 16 * db + frv, b = bh >> 3, h = bh & 7;
        float v[8];
#pragma unroll
        for (int i = 0; i < 8; ++i) { const int key = 32 * st + (i < 4 ? 4 * fqv + i : 16 + 4 * fqv + i - 4);
            v[i] = Pp->in[I_CV][(((size_t)(l * 16 + b) * 512 + key) * 8 + h) * 64 + d]; }
        u32x4 w; w.x = cvt_pk_bf16(v[0], v[1]); w.y = cvt_pk_bf16(v[2], v[3]); w.z = cvt_pk_bf16(v[4], v[5]); w.w = cvt_pk_bf16(v[6], v[7]);
        *(u32x4*)((bf16_t*)(Pp->ws + W_VFS) + ((((size_t)(l * 128 + bh) * 18 + st) * 4 + db) * 64 + ln) * 8) = w;
    }
}

__device__ __forceinline__ void prologue_phase(const Ctx& C, LAS unsigned char* lds) {
    const CParams Pp = get_params();
    const int nconv = (C.G > 8) ? 1 : NL;
    for (int l = 0; l < nconv; ++l) convert_layer(C, lds, l);
    for (int item = C.gtid; item < NL * 512 * 8; item += C.NT) {
        const int j = item & 7, grp = (item >> 3) & 511, l = item >> 12;
        const float* src = j < 3 ? Pp->in[I_FCW] + (size_t)(l * 3 + j) * 4096 + grp * 4 : j < 6 ? Pp->in[I_FCW] + (size_t)(l * 3 + j - 3) * 4096 + 2048 + grp * 4
                         : j == 6 ? Pp->in[I_FCB] + (size_t)l * 4096 + grp * 4 : Pp->in[I_FCB] + (size_t)l * 4096 + 2048 + grp * 4;
        *(f32x4*)(Pp->ws + W_CW + (size_t)item * 16) = *(const f32x4*)src;
    }
    for (int item = C.gtid; item < NL * 2560 * 16; item += C.NT) {
        const int n = item % 2560, kc = (item / 2560) & 15, l = item / (2560 * 16);
        const float* W = Pp->in[I_WIN] + (size_t)l * DM * NPROJ + (size_t)kc * 64 * NPROJ + n;
        const float* gk = Pp->in[I_LN2G] + (l ? l - 1 : 0) * 1024 + kc * 64;
        const float* bk = Pp->in[I_LN2B] + (l ? l - 1 : 0) * 1024 + kc * 64;
        float cs = 0.f, bs = 0.f;
#pragma unroll 16
        for (int k = 0; k < 64; ++k) { const float w = W[(size_t)k * NPROJ]; const float wf = l ? w * gk[k] : w; cs += bf1(f2bf(wf)); bs += l ? bk[k] * w : 0.f; }
        float* dst = (float*)(Pp->ws + W_CSP) + (size_t)item * 2;
        dst[0] = cs; dst[1] = bs;
    }
    for (int item = C.gtid; item < MT * 4; item += C.NT) { typedef float f32x2v __attribute__((ext_vector_type(2))); *(f32x2v*)(Pp->ws + W_STA + (size_t)item * 8) = (f32x2v){0.f, 256.f * (1.f - LN_EPS)}; }
    for (int item = C.gtid; item < 2048; item += C.NT) ((float*)(Pp->ws + W_ONE))[item] = item < 1024 ? 1.f : 0.f;
    for (int row0 = C.gw; row0 < MT; row0 += 3 * C.NGW) {
        f32x4 va[4], vb[4], vc[4];
        const int r1 = row0 + C.NGW, r2 = row0 + 2 * C.NGW;
        ln_in_load(row0 < MP ? Pp->in[I_XP] + (size_t)row0 * 1024 : Pp->in[I_XS] + (size_t)(row0 - MP) * 1024, va, C.lane);
        if (r1 < MT) ln_in_load(r1 < MP ? Pp->in[I_XP] + (size_t)r1 * 1024 : Pp->in[I_XS] + (size_t)(r1 - MP) * 1024, vb, C.lane);
        if (r2 < MT) ln_in_load(r2 < MP ? Pp->in[I_XP] + (size_t)r2 * 1024 : Pp->in[I_XS] + (size_t)(r2 - MP) * 1024, vc, C.lane);
        ln_in_compute(va, Pp->in[I_LNG], Pp->in[I_LNB], (bf16_t*)(Pp->ws + W_XV) + (size_t)row0 * 1024, C.lane);
        if (r1 < MT) ln_in_compute(vb, Pp->in[I_LNG], Pp->in[I_LNB], (bf16_t*)(Pp->ws + W_XV) + (size_t)r1 * 1024, C.lane);
        if (r2 < MT) ln_in_compute(vc, Pp->in[I_LNG], Pp->in[I_LNB], (bf16_t*)(Pp->ws + W_XV) + (size_t)r2 * 1024, C.lane);
    }
}

__device__ __forceinline__ void attn_unit(const bf16_t* __restrict__ Q, const bf16_t* __restrict__ K, const bf16_t* __restrict__ VFp,
                                          int nsteps, int dist0, const LAS float* bias, bf16_t* out, int nqb, int lane) {
    const int fr = lane & 15, fq = lane >> 4;
    bf16x8 qf[4][2];
#pragma unroll
    for (int qb = 0; qb < 4; ++qb)
#pragma unroll
        for (int ds = 0; ds < 2; ++ds) {
            if (qb < nqb) qf[qb][ds] = *(const bf16x8*)(Q + (size_t)(16 * qb + fr) * 64 + 32 * ds + 8 * fq);
            else qf[qb][ds] = (bf16x8){0, 0, 0, 0, 0, 0, 0, 0};
        }
    f32x4 o[4][4]; float mrow[4], lrow[4];
#pragma unroll
    for (int a = 0; a < 4; ++a) { mrow[a] = -1e30f; lrow[a] = 0.f;
#pragma unroll
        for (int b = 0; b < 4; ++b) o[a][b] = (f32x4){0.f, 0.f, 0.f, 0.f}; }
    bf16x8 kf[2][2];
    {
        const bf16_t* kp = K + (size_t)fr * 64 + 8 * fq;
#pragma unroll
        for (int kb = 0; kb < 2; ++kb)
#pragma unroll
            for (int ds = 0; ds < 2; ++ds) kf[kb][ds] = *(const bf16x8*)(kp + kb * 1024 + ds * 32);
    }
    const float bfar = bias[191];
    for (int st = 0; st < nsteps; ++st) {
        bf16x8 kn[2][2], vf[4];
        const bf16_t* vp = VFp + (size_t)st * 2048 + lane * 8;
#pragma unroll
        for (int db = 0; db < 4; ++db) vf[db] = *(const bf16x8*)(vp + db * 512);
        if (st + 1 < nsteps) {
            const bf16_t* kp = K + (size_t)(32 * (st + 1) + fr) * 64 + 8 * fq;
#pragma unroll
            for (int kb = 0; kb < 2; ++kb)
#pragma unroll
                for (int ds = 0; ds < 2; ++ds) kn[kb][ds] = *(const bf16x8*)(kp + kb * 1024 + ds * 32);
        } else {
#pragma unroll
            for (int kb = 0; kb < 2; ++kb)
#pragma unroll
                for (int ds = 0; ds < 2; ++ds) kn[kb][ds] = kf[kb][ds];
        }
        f32x4 s[2][4];
#pragma unroll
        for (int kb = 0; kb < 2; ++kb)
#pragma unroll
            for (int qb = 0; qb < 4; ++qb) {
                s[kb][qb] = __builtin_amdgcn_mfma_f32_16x16x32_bf16(kf[kb][0], qf[qb][0], (f32x4){0.f, 0.f, 0.f, 0.f}, 0, 0, 0);
                s[kb][qb] = __builtin_amdgcn_mfma_f32_16x16x32_bf16(kf[kb][1], qf[qb][1], s[kb][qb], 0, 0, 0);
            }
        const int dbase = dist0 + fr - 32 * st - 4 * fq;
        const bool far = (dist0 - 32 * st - 31) >= 128;
#pragma unroll
        for (int qb = 0; qb < 4; ++qb) {
            float mx = -1e30f;
            if (far) {
#pragma unroll
                for (int kb = 0; kb < 2; ++kb)
#pragma unroll
                    for (int r = 0; r < 4; ++r) { const float v = s[kb][qb][r] + bfar; s[kb][qb][r] = v; mx = fmaxf(mx, v); }
            } else {
#pragma unroll
                for (int kb = 0; kb < 2; ++kb)
#pragma unroll
                    for (int r = 0; r < 4; ++r) {
                        int d = dbase + 16 * qb - 16 * kb - r; d = d < -63 ? -63 : d; d = d > 128 ? 128 : d;
                        const float v = s[kb][qb][r] + bias[d + 63]; s[kb][qb][r] = v; mx = fmaxf(mx, v);
                    }
            }
            mx = xmax32(xmax16(mx));
            if (__any(mx > mrow[qb])) {
                const float mnew = fmaxf(mrow[qb], mx), al = fexp2(mrow[qb] - mnew); mrow[qb] = mnew; lrow[qb] *= al;
#pragma unroll
                for (int db = 0; db < 4; ++db) o[db][qb] = o[db][qb] * al;
            }
            const float mcur = mrow[qb];
            float ls = 0.f;
#pragma unroll
            for (int kb = 0; kb < 2; ++kb)
#pragma unroll
                for (int r = 0; r < 4; ++r) { const float p = fexp2(s[kb][qb][r] - mcur); s[kb][qb][r] = p; ls += p; }
            lrow[qb] += ls;
            u32x4 w; w.x = cvt_pk_bf16(s[0][qb][0], s[0][qb][1]); w.y = cvt_pk_bf16(s[0][qb][2], s[0][qb][3]); w.z = cvt_pk_bf16(s[1][qb][0], s[1][qb][1]); w.w = cvt_pk_bf16(s[1][qb][2], s[1][qb][3]);
            const bf16x8 pb = __builtin_bit_cast(bf16x8, w);
#pragma unroll
            for (int db = 0; db < 4; ++db) o[db][qb] = __builtin_amdgcn_mfma_f32_16x16x32_bf16(vf[db], pb, o[db][qb], 0, 0, 0);
        }
#pragma unroll
        for (int kb = 0; kb < 2; ++kb)
#pragma unroll
            for (int ds = 0; ds < 2; ++ds) kf[kb][ds] = kn[kb][ds];
    }
#pragma unroll
    for (int qb = 0; qb < 4; ++qb) {
        if (qb < nqb) {
            float lt = xsum32(xsum16(lrow[qb]));
            const float inv = 1.f / lt;
#pragma unroll
            for (int db = 0; db < 4; ++db) {
                const f32x4 v = o[db][qb] * inv; u32x2 w; w.x = cvt_pk_bf16(v[0], v[1]); w.y = cvt_pk_bf16(v[2], v[3]);
                *(u32x2*)(out + (size_t)(16 * qb + fr) * 1024 + 16 * db + 4 * fq) = w;
            }
        }
    }
}

__device__ __forceinline__ void sconv_phase(const Ctx& C, int l);
__device__ __forceinline__ void attn_phase(const Ctx& C, int l, LAS unsigned char* lds) {
    const CParams Pp = get_params();
    LAS float* bt = (LAS float*)lds;
    for (int i = C.tid; i < 8 * 192; i += 512) bt[i] = Pp->in[I_RELB][l * 1536 + i] * LOG2E;
    __syncthreads();
    const bf16_t* Qh = (const bf16_t*)(Pp->ws + W_QH); const bf16_t* Kh = (const bf16_t*)(Pp->ws + W_KH); const bf16_t* VF = (const bf16_t*)(Pp->ws + W_VF);
    bf16_t* mix = (bf16_t*)(Pp->ws + W_MIX);
    if (C.wave < 4) sconv_phase(C, l);
    const int vb = (C.G % 8 == 0) ? (C.bid % 8) * (C.G / 8) + C.bid / 8 : C.bid;
    const int gwv = vb * 8 + C.wave;
    for (int u = gwv; u < 8192; u += C.NGW) {
        const int bh = u >> 5, c = ((u & 31) + 8 * (u >> 11)) & 31, b = bh >> 3, h = bh & 7;
        const int nkc = (c < 8 ? c : 8) + 1, m0 = b * 2048 + c * 64, k0 = m0 - (nkc - 1) * 64;
        attn_unit(Qh + ((size_t)h * MT + m0) * 64, Kh + ((size_t)h * MT + k0) * 64, VF + ((size_t)h * NCHK + (k0 >> 6)) * 4096,
                  2 * nkc, m0 - k0, bt + h * 192, mix + (size_t)m0 * 1024 + h * 64, 4, C.lane);
    }
    {
        const bool bal = (C.NGW == 2048);
        for (int us = bal ? (((gwv & 15) == 0) ? (gwv >> 4) : 128) : gwv; us < 128; us += bal ? 128 : C.NGW) {
            const int b = us >> 3, h = us & 7;
            attn_unit(Qh + ((size_t)h * MT + MP + b * 32) * 64, (const bf16_t*)(Pp->ws + W_KS) + (size_t)(l * 128 + b * 8 + h) * 544 * 64,
                      (const bf16_t*)(Pp->ws + W_VFS) + (size_t)(l * 128 + b * 8 + h) * 18 * 2048, 17, 512, bt + h * 192,
                      mix + (size_t)(MP + b * 32) * 1024 + h * 64, 2, C.lane);
        }
    }
    if (C.wave >= 4) sconv_phase(C, l);
}

__device__ __forceinline__ void sconv_phase(const Ctx& C, int l) {
    const CParams Pp = get_params();
    const bf16_t* G = (const bf16_t*)(Pp->ws + W_G); bf16_t* mix = (bf16_t*)(Pp->ws + W_MIX);
    const int c = (C.gtid & 31) * 8;
    f32x4 w0[2], w1[2], w2[2], bs[2];
#pragma unroll
    for (int k = 0; k < 2; ++k) {
        w0[k] = *(const f32x4*)(Pp->in[I_SCW] + (size_t)(l * 3 + 0) * 256 + c + 4 * k); w1[k] = *(const f32x4*)(Pp->in[I_SCW] + (size_t)(l * 3 + 1) * 256 + c + 4 * k);
        w2[k] = *(const f32x4*)(Pp->in[I_SCW] + (size_t)(l * 3 + 2) * 256 + c + 4 * k); bs[k] = *(const f32x4*)(Pp->in[I_SCB] + (size_t)l * 256 + c + 4 * k);
    }
    for (int item = C.gtid; item < MT * 32; item += C.NT) {
        const int row = item >> 5;
        const bool smp = row >= MP; const int s = smp ? ((row - MP) & 31) : (row & 2047), b = smp ? ((row - MP) >> 5) : (row >> 11);
        const bf16_t* gr = G + (size_t)row * 768 + c;
        f32x4 gb0, gb1, a0, a1, x0, x1, i0[2], i1[2], i2[2];
        unpack8(*(const u32x4*)gr, gb0, gb1); unpack8(*(const u32x4*)(gr + 256), a0, a1); unpack8(*(const u32x4*)(gr + 512), x0, x1);
        i0[0] = a0 * x0; i0[1] = a1 * x1;
        if (s >= 1) { unpack8(*(const u32x4*)(gr - 768 + 256), a0, a1); unpack8(*(const u32x4*)(gr - 768 + 512), x0, x1); i1[0] = a0 * x0; i1[1] = a1 * x1; }
        else if (smp) { const float* cp = Pp->in[I_CSC] + ((size_t)(l * 16 + b) * 2 + 1) * 256 + c; i1[0] = *(const f32x4*)cp; i1[1] = *(const f32x4*)(cp + 4); }
        else { i1[0] = (f32x4){0.f, 0.f, 0.f, 0.f}; i1[1] = i1[0]; }
        if (s >= 2) { unpack8(*(const u32x4*)(gr - 2 * 768 + 256), a0, a1); unpack8(*(const u32x4*)(gr - 2 * 768 + 512), x0, x1); i2[0] = a0 * x0; i2[1] = a1 * x1; }
        else if (smp) { const float* cp = Pp->in[I_CSC] + ((size_t)(l * 16 + b) * 2 + s) * 256 + c; i2[0] = *(const f32x4*)cp; i2[1] = *(const f32x4*)(cp + 4); }
        else { i2[0] = (f32x4){0.f, 0.f, 0.f, 0.f}; i2[1] = i2[0]; }
        const f32x4 r0 = gb0 * (w0[0] * i2[0] + w1[0] * i1[0] + w2[0] * i0[0] + bs[0]);
        const f32x4 r1 = gb1 * (w0[1] * i2[1] + w1[1] * i1[1] + w2[1] * i0[1] + bs[1]);
        *(u32x4*)(mix + (size_t)row * 1024 + 768 + c) = pack8(r0, r1);
        if (!smp && s >= 2046) { float* p = Pp->out + O_SCP + ((size_t)(l * 32 + b) * 2 + (s - 2046)) * 256 + c; *(f32x4*)p = i0[0]; *(f32x4*)(p + 4) = i0[1]; }
        if (smp && s >= 30) { float* p = Pp->out + O_SCS + ((size_t)(l * 16 + b) * 2 + (s - 30)) * 256 + c; *(f32x4*)p = i0[0]; *(f32x4*)(p + 4) = i0[1]; }
    }
}

__device__ __forceinline__ void scan_phase(const Ctx& C, int l, LAS unsigned char* lds) {
    const CParams Pp = get_params();
    bf16_t* U2 = (bf16_t*)(Pp->ws + W_U2); const float* HL = (const float*)(Pp->ws + W_HLOC);
    {
        const int gw2 = C.wave * C.G + C.bid;
        for (int w = gw2; w < 512; w += C.NGW) {
            const int idx = w * 64 + C.lane, p = idx & 63, g = (idx >> 6) & 15, b = idx >> 10;
            const float lr = Pp->in[I_LAMRE][(l * 16 + g) * 64 + p], li = Pp->in[I_LAMIM][(l * 16 + g) * 64 + p], dt = __expf(Pp->in[I_LOGDT][l * 16 + g]);
            float ar, ai; cpow_exp(lr, li, dt, 64.f, ar, ai);
            float hr = 0.f, hi = 0.f;
#pragma unroll 8
            for (int c = 0; c < 32; ++c) {
                const size_t rowi = (size_t)g * 1024 + b * 32 + c;
                U2[rowi * 1152 + 1024 + p] = f2bf(hr); U2[rowi * 1152 + 1088 + p] = f2bf(hi);
                float xr = 0.f, xi = 0.f;
#pragma unroll
                for (int ks = 0; ks < 4; ++ks) { xr += HL[((size_t)ks * 16384 + rowi) * 128 + p]; xi += HL[((size_t)ks * 16384 + rowi) * 128 + 64 + p]; }
                const float nr = ar * hr - ai * hi + xr, ni = ar * hi + ai * hr + xi; hr = nr; hi = ni;
            }
            Pp->out[O_SRP + ((size_t)(l * 32 + b) * 16 + g) * 64 + p] = hr; Pp->out[O_SIP + ((size_t)(l * 32 + b) * 16 + g) * 64 + p] = hi;
        }
    }
    LAS float* us = (LAS float*)lds; LAS float* hsr = us + 512; LAS float* hsi = hsr + 32 * 65;
    const bf16_t* US = (const bf16_t*)(Pp->ws + W_US); bf16_t* Z = (bf16_t*)(Pp->ws + W_Z);
    for (int unit = C.bid; unit < 256; unit += C.G) {
        const int b = unit >> 4, g = unit & 15;
        { const int t = C.tid >> 4, c = C.tid & 15; us[C.tid] = bf1(US[(size_t)(b * 32 + t) * 256 + g * 16 + c]); }
        __syncthreads();
        if (C.tid < 64) {
            const int p = C.tid;
            const float lr = Pp->in[I_LAMRE][(l * 16 + g) * 64 + p], li = Pp->in[I_LAMIM][(l * 16 + g) * 64 + p], dt = __expf(Pp->in[I_LOGDT][l * 16 + g]);
            float ar, ai, cr, ci; cpow_exp(lr, li, dt, 1.f, ar, ai); ssm_cf(lr, li, dt, cr, ci);
            const float* br = Pp->in[I_BRE] + ((size_t)(l * 16 + g) * 64 + p) * 16; const float* bi = Pp->in[I_BIM] + ((size_t)(l * 16 + g) * 64 + p) * 16;
            f32x4 Br[4], Bi[4];
#pragma unroll
            for (int q = 0; q < 4; ++q) { const f32x4 b_r = *(const f32x4*)(br + 4 * q), b_i = *(const f32x4*)(bi + 4 * q); Br[q] = b_r * cr - b_i * ci; Bi[q] = b_i * cr + b_r * ci; }
            const size_t si = ((size_t)(l * 16 + b) * 16 + g) * 64 + p;
            float hr = Pp->in[I_SRE][si], hi = Pp->in[I_SIM][si];
            for (int t = 0; t < 32; ++t) {
                float bur = 0.f, bui = 0.f;
#pragma unroll
                for (int q = 0; q < 4; ++q)
#pragma unroll
                    for (int e = 0; e < 4; ++e) { const float uu = us[t * 16 + 4 * q + e]; bur += Br[q][e] * uu; bui += Bi[q][e] * uu; }
                const float nr = ar * hr - ai * hi + bur, ni = ar * hi + ai * hr + bui; hr = nr; hi = ni;
                hsr[t * 65 + p] = hr; hsi[t * 65 + p] = hi;
            }
            Pp->out[O_SRS + si] = hr; Pp->out[O_SIS + si] = hi;
        }
        __syncthreads();
        {
            const int t = C.tid >> 4, c = C.tid & 15;
            const float* cre = Pp->in[I_CRE] + ((size_t)(l * 16 + g) * 16 + c) * 64; const float* cim = Pp->in[I_CIM] + ((size_t)(l * 16 + g) * 16 + c) * 64;
            float y = 0.f;
            for (int p = 0; p < 64; ++p) y += cre[p] * hsr[t * 65 + p] - cim[p] * hsi[t * 65 + p];
            y += Pp->in[I_SD][l * 256 + g * 16 + c] * us[C.tid];
            Z[(size_t)(MP + b * 32 + t) * 256 + g * 16 + c] = f2bf(gelu_tanh(y));
        }
        __syncthreads();
    }
}


#define XB_TMO      128
#define XB_XCNT(j)  (256  + 64 * (j))
#define XB_XSUB(j)  (1280 + 64 * (j))
#define XB_XGEN(j)  (2304 + 64 * (j))
#define XB_TOP      3328
#define XB_TOPGEN   3392
#define XCD_BAR_WORDS 3456
#define XB_SPIN_CAP (1u << 18)
__device__ __forceinline__ unsigned xb_ld(unsigned* p)              { return __hip_atomic_load(p, __ATOMIC_RELAXED, __HIP_MEMORY_SCOPE_AGENT); }
__device__ __forceinline__ unsigned xb_add(unsigned* p, unsigned v) { return __hip_atomic_fetch_add(p, v, __ATOMIC_RELAXED, __HIP_MEMORY_SCOPE_AGENT); }
__device__ __forceinline__ unsigned xb_xcc_id() { return (unsigned)__builtin_amdgcn_s_getreg((3 << 11) | 20) & 0xFu; }
#define XB_SPIN(cond, bar) do { unsigned _sp = 0; while (cond) { __builtin_amdgcn_s_sleep(1); \
    if ((++_sp & 255u) == 0u) { if (xb_ld(&(bar)[XB_TMO])) break; if (_sp > XB_SPIN_CAP) { atomicAdd(&(bar)[XB_TMO], 1u); break; } } } } while (0)
struct XcdBarrier { unsigned* bar; unsigned x; volatile LAS unsigned* st; };
__device__ __forceinline__ void xcd_barrier_complete(unsigned* bar, unsigned x, unsigned& nloc, unsigned& nx) {
    const unsigned G = gridDim.x * gridDim.y * gridDim.z;
    unsigned sum, cnt, mine, sp = 0u;
    for (;;) {
        sum = 0u; cnt = 0u; mine = 0u;
#pragma unroll
        for (unsigned j = 0; j < 16; ++j) { const unsigned c = xb_ld(&bar[XB_XCNT(j)]); sum += c; cnt += (c > 0u) ? 1u : 0u; mine = (j == x) ? c : mine; }
        if (sum == G) break;
        __builtin_amdgcn_s_sleep(1);
        if ((++sp & 255u) == 0u) { if (xb_ld(&bar[XB_TMO])) break; if (sp > XB_SPIN_CAP) { atomicAdd(&bar[XB_TMO], 1u); break; } }
    }
    nloc = mine > 0u ? mine : 1u; nx = cnt > 0u ? cnt : 1u;
}
__device__ __forceinline__ void xcd_barrier(const XcdBarrier& b) {
    asm volatile("s_waitcnt vmcnt(0)" ::: "memory");
    __syncthreads();
    if (threadIdx.x == 0) {
        unsigned* bar = b.bar;
        __builtin_amdgcn_s_waitcnt(0);
        unsigned nloc = b.st[0], nx = b.st[1];
        if (nloc == 0u) { xcd_barrier_complete(bar, b.x, nloc, nx); b.st[0] = nloc; b.st[1] = nx; }
        const unsigned old = xb_add(&bar[XB_XSUB(b.x)], 1u);
        const unsigned gen = old / nloc;
        if (old + 1u == (gen + 1u) * nloc) {
            __builtin_amdgcn_fence(__ATOMIC_RELEASE, "agent");
            asm volatile("s_waitcnt vmcnt(0)" ::: "memory");
            const unsigned og = xb_add(&bar[XB_TOP], 1u);
            const unsigned tg = og / nx;
            if (og + 1u == (tg + 1u) * nx) xb_add(&bar[XB_TOPGEN], 1u);
            else XB_SPIN(xb_ld(&bar[XB_TOPGEN]) == tg, bar);
            __builtin_amdgcn_fence(__ATOMIC_ACQUIRE, "agent");
            xb_add(&bar[XB_XGEN(b.x)], 1u);
            asm volatile("s_waitcnt vmcnt(0)" ::: "memory");
        } else {
            XB_SPIN(xb_ld(&bar[XB_XGEN(b.x)]) == gen, bar);
            __builtin_amdgcn_fence(__ATOMIC_ACQUIRE, "agent");
            asm volatile("s_waitcnt vmcnt(0)" ::: "memory");
        }
    }
    __syncthreads();
}

enum { ST_PROJ = 0, ST_ATTN, ST_HLOC, ST_SCAN, ST_YSSM, ST_GLU, ST_OUT, ST_LN1, ST_FFIN, ST_FFOUT, ST_PER_LAYER };
constexpr int N_STEPS = 2 + NL * ST_PER_LAYER + 1;

__global__ void __launch_bounds__(512, 2) mega(Params P) {
    extern __shared__ __attribute__((aligned(16))) unsigned char lds_raw[];
    LAS unsigned char* lds = (LAS unsigned char*)lds_raw;
    const int step_lo = get_params()->lo, step_hi = get_params()->hi;
    volatile LAS unsigned* xst = (volatile LAS unsigned*)(lds + LDS_BYTES - 64);
    if (threadIdx.x == 0) { xst[0] = 0u; xst[1] = 0u; }
    __syncthreads();
    XcdBarrier xbar; xbar.bar = (unsigned*)(get_params()->ws + 4096); xbar.x = xb_xcc_id(); xbar.st = xst;
    if (step_hi - step_lo > 1 && threadIdx.x == 0) (void)xb_add(&xbar.bar[XB_XCNT(xbar.x)], 1u);
    for (int step = step_lo; step < step_hi; ++step) {
        bool sync_after = true;
        const CParams Pp = get_params();
        int tid_ = threadIdx.x, bid_ = blockIdx.x, G_ = gridDim.x; asm volatile("" : "+v"(tid_)); asm volatile("" : "+s"(bid_), "+s"(G_));
        Ctx C; C.tid = tid_; C.lane = tid_ & 63; C.wave = __builtin_amdgcn_readfirstlane(tid_ >> 6); C.G = G_; C.bid = bid_;
        C.gtid = bid_ * 512 + tid_; C.NT = G_ * 512; C.gw = bid_ * 8 + C.wave; C.NGW = G_ * 8;
        if (step == 0) { prologue_phase(C, lds); __syncthreads(); ssm_T_phase(C, 0, lds); }
        else if (step == 1) {
            ssm_fill_phase(C, 0);
            for (int item = C.gtid; item < NL * 2560; item += C.NT) {
                const int l = item / 2560, n = item % 2560; const float* src = (const float*)(Pp->ws + W_CSP) + ((size_t)l * 16 * 2560 + n) * 2;
                float cs = 0.f, bs = 0.f;
#pragma unroll
                for (int kc = 0; kc < 16; ++kc) { cs += src[(size_t)kc * 2560 * 2]; bs += src[(size_t)kc * 2560 * 2 + 1]; }
                float* dst = (float*)(Pp->ws + W_CS) + l * CS_L + n; dst[0] = cs; dst[2560] = bs;
            }
        }
        else if (step == N_STEPS - 1) { ln_phase(C, Pp->ws, Pp->in[I_LN2G] + (NL - 1) * 1024, Pp->in[I_LN2B] + (NL - 1) * 1024, Pp->out); }
        else {
            const int l = (step - 2) / ST_PER_LAYER, st = (step - 2) % ST_PER_LAYER;
            bool is_gemm = false; pg8::Gemm g; Epi E; E.l = l; E.mode = EM_PROJ; E.sub = 0;
            g.batch = 1; g.kshift = 0; g.ablk = 64; g.nM1 = 1 << 30; g.off2 = 0;
            switch (st) {
            case ST_PROJ: is_gemm = true; E.mode = EM_PROJ; g.A = (const bf16_t*)(Pp->ws + W_XV); g.Bt = (const bf16_t*)(Pp->ws + W_WIN) + (size_t)l * NPROJ * DM; g.M = MT; g.N = NPROJ; g.K = DM; g.lda = DM; g.ldb = DM; break;
            case ST_ATTN: attn_phase(C, l, lds); if (l + 1 < NL) { __syncthreads(); ssm_T_phase(C, l + 1, lds); } sync_after = false; break;
            case ST_HLOC: is_gemm = true; E.mode = EM_HLOC; g.A = (const bf16_t*)(Pp->ws + W_U2); g.Bt = (const bf16_t*)(Pp->ws + W_HM); g.M = 1024; g.N = 256; g.K = 256; g.lda = 1152; g.ldb = 1024; g.batch = 64; g.kshift = 2; break;
            case ST_SCAN: scan_phase(C, l, lds); break;
            case ST_YSSM: is_gemm = true; E.mode = EM_YSSM; g.A = (const bf16_t*)(Pp->ws + W_U2); g.Bt = (const bf16_t*)(Pp->ws + W_YK); g.M = 1024; g.N = 1024; g.K = 1152; g.lda = 1152; g.ldb = 1152; g.batch = 16; break;
            case ST_GLU: is_gemm = true; E.mode = EM_GLU; g.A = (const bf16_t*)(Pp->ws + W_Z); g.Bt = (const bf16_t*)(Pp->ws + W_WGLU) + (size_t)l * 65536; g.M = MT; g.N = 256; g.K = 256; g.lda = 256; g.ldb = 256; break;
            case ST_OUT: if (l + 1 < NL && C.bid >= 8 && C.G > 8) { Ctx C2 = C; C2.gtid = (C.bid - 8) * 512 + C.tid; C2.NT = (C.G - 8) * 512; ssm_fill_phase(C2, l + 1); }
                         else if (l + 1 < NL && C.G <= 8) ssm_fill_phase(C, l + 1);
                         is_gemm = true; E.mode = EM_RES; g.A = (const bf16_t*)(Pp->ws + W_MIX); g.Bt = (const bf16_t*)(Pp->ws + W_WOUT) + (size_t)l * DM * DM; g.M = MT; g.N = DM; g.K = DM; g.lda = DM; g.ldb = DM; break;
            case ST_LN1: ln_phase(C, Pp->ws, Pp->in[I_LN1G] + l * 1024, Pp->in[I_LN1B] + l * 1024, nullptr); break;
            case ST_FFIN: is_gemm = true; E.mode = EM_FFIN; g.A = (const bf16_t*)(Pp->ws + W_XV) - 2 * DM; g.Bt = (const bf16_t*)(Pp->ws + W_WFFI) + (size_t)l * DFF2 * DM; g.M = (NTP + NTS) * 256; g.N = DFF2; g.K = DM; g.lda = DM; g.ldb = DM; g.ablk = 62; g.nM1 = NTP; g.off2 = (unsigned)MP * DM * 2u; break;
            case ST_FFOUT: is_gemm = true; E.mode = EM_RES; E.sub = 1; g.A = (const bf16_t*)Pp->out; g.Bt = (const bf16_t*)(Pp->ws + W_WFFO) + (size_t)l * DM * DFF; g.M = MT; g.N = DM; g.K = DFF; g.lda = DFF; g.ldb = DFF; break;
            default: break;
            }
            if (is_gemm) { __syncthreads(); pg8::Order S; S.init(g.M, g.N, g.batch, C.G, (int)C.bid); S.rev = (st == ST_FFOUT || st == ST_OUT) ? 1 : 0; pg8::gemm_phase<Epi>(lds, g, S, E, C.tid); }
            if (st == ST_FFOUT && l + 1 < NL && C.G > 8 && C.bid >= 8) {
                Ctx C2 = C; C2.bid = C.bid - 8; C2.G = C.G - 8; C2.gtid = C2.bid * 512 + C.tid; C2.NT = C2.G * 512; C2.gw = C2.bid * 8 + C.wave; C2.NGW = C2.G * 8;
                convert_layer(C2, lds, l + 1);
            }
        }
        if (step + 1 < step_hi) {
            if (!sync_after) __syncthreads(); else if (step == step_lo) cg::this_grid().sync(); else xcd_barrier(xbar);
        }
    }
}

extern "C" void kernel_launch(void* const* d_in, const int* in_sizes, int n_in, void* d_out, int out_size, void* d_ws, size_t ws_size, hipStream_t stream) {
    static int grid = 0;
    if (grid == 0) {
        if (n_in != 32 || (size_t)out_size != O_END || ws_size < W_END) { fprintf(stderr, "kernel_launch: unexpected sizes n_in=%d out=%d ws=%zu (need %zu)\n", n_in, out_size, ws_size, (size_t)W_END); grid = -1; return; }
        int dev = 0, cus = 0, per_cu = 0;
        hipGetDevice(&dev); hipDeviceGetAttribute(&cus, hipDeviceAttributeMultiprocessorCount, dev);
        hipFuncSetAttribute((const void*)mega, hipFuncAttributeMaxDynamicSharedMemorySize, LDS_BYTES);
        hipOccupancyMaxActiveBlocksPerMultiprocessor(&per_cu, (const void*)mega, 512, LDS_BYTES);
        if (per_cu < 1) { fprintf(stderr, "kernel_launch: occupancy query says %d blocks/CU\n", per_cu); per_cu = 1; }
        (void)hipGetLastError();
        grid = cus;
    }
    if (grid < 0) return;
    Params p{};
    for (int i = 0; i < 32; ++i) p.in[i] = (const float*)d_in[i];
    p.out = (float*)d_out; p.ws = (unsigned char*)d_ws;
#if SINGLE_LAUNCH
    hipMemsetAsync(d_ws, 0, 65536, stream);
    p.lo = 0; p.hi = N_STEPS;
    void* args[] = {&p};
    hipError_t e = hipLaunchCooperativeKernel((const void*)mega, dim3(grid), dim3(512), args, LDS_BYTES, stream);
    if (e != hipSuccess) fprintf(stderr, "cooperative launch failed: %s (grid %d)\n", hipGetErrorString(e), grid);
#else
#ifndef DBG_NSTEP
#define DBG_NSTEP N_STEPS
#endif
    for (int s = 0; s < DBG_NSTEP; ++s) {
        p.lo = s; p.hi = s + 1;
        hipLaunchKernelGGL(mega, dim3(grid), dim3(512), LDS_BYTES, stream, p);
    }
#ifdef DBG_DUMP
    hipMemcpyAsync(d_out, (unsigned char*)d_ws + DBG_DUMP, (size_t)500 * 1024 * 1024, hipMemcpyDeviceToDevice, stream);
#endif
#endif
}
```

```cpp
#include <hip/hip_runtime.h>
#include <hip/hip_cooperative_groups.h>
#include <cstdio>
#include <cstdint>
namespace cg = cooperative_groups;

#ifndef SINGLE_LAUNCH
#define SINGLE_LAUNCH 1
#endif

#define LAS __attribute__((address_space(3)))
typedef unsigned short bf16_t;
typedef short bf16x8 __attribute__((ext_vector_type(8)));
typedef float f32x4 __attribute__((ext_vector_type(4)));
typedef unsigned u32x4 __attribute__((ext_vector_type(4)));
typedef unsigned u32x2 __attribute__((ext_vector_type(2)));

constexpr int MP = 65536, MS = 512, MT = MP + MS;
constexpr int DM = 1024, NPROJ = 2560, DFF2 = 4096, DFF = 2048, NL = 4;
constexpr float ALPHA = 1.681792830507429f;
constexpr float LN_EPS = 1e-5f;
constexpr float LOG2E = 1.4426950408889634f;
constexpr int NCHK = 1032;

constexpr size_t O_Y = 0;
constexpr size_t O_KP = (size_t)MT * DM;
constexpr size_t O_VP = O_KP + (size_t)NL * 32 * 512 * 512;
constexpr size_t O_KS = O_VP + (size_t)NL * 32 * 512 * 512;
constexpr size_t O_VS = O_KS + (size_t)NL * 16 * 32 * 512;
constexpr size_t O_SRP = O_VS + (size_t)NL * 16 * 32 * 512;
constexpr size_t O_SIP = O_SRP + (size_t)NL * 32 * 16 * 64;
constexpr size_t O_SRS = O_SIP + (size_t)NL * 32 * 16 * 64;
constexpr size_t O_SIS = O_SRS + (size_t)NL * 16 * 16 * 64;
constexpr size_t O_SCP = O_SIS + (size_t)NL * 16 * 16 * 64;
constexpr size_t O_SCS = O_SCP + (size_t)NL * 32 * 2 * 256;
constexpr size_t O_FFP = O_SCS + (size_t)NL * 16 * 2 * 256;
constexpr size_t O_FFS = O_FFP + (size_t)NL * 32 * 2 * 4096;
constexpr size_t O_END = O_FFS + (size_t)NL * 16 * 2 * 4096;
static_assert(O_END == 138903552, "out size");

constexpr size_t W_WIN = 1u << 20;
constexpr size_t W_WOUT = W_WIN + (size_t)NL * NPROJ * DM * 2;
constexpr size_t W_WFFI = W_WOUT + (size_t)NL * DM * DM * 2;
constexpr size_t W_WFFO = W_WFFI + (size_t)NL * DFF2 * DM * 2;
constexpr size_t W_WGLU = W_WFFO + (size_t)NL * DM * DFF * 2;
constexpr size_t W_SSMT = W_WGLU + (size_t)NL * 256 * 256 * 2;
constexpr size_t W_YK = W_SSMT + (size_t)16 * 64 * 256 * 4;
constexpr size_t W_HM = W_YK + (size_t)16 * 1024 * 1152 * 2;
constexpr size_t W_HLOC = W_HM + (size_t)16 * 256 * 1024 * 2;
constexpr size_t W_XV = W_HLOC + (size_t)4 * 16 * 1024 * 128 * 4;
constexpr size_t W_KS = W_XV + (size_t)MT * DM * 2;
constexpr size_t W_VFS = W_KS + (size_t)NL * 128 * 544 * 64 * 2;
constexpr size_t W_US = W_VFS + (size_t)NL * 128 * 18 * 2048 * 2;
constexpr size_t W_CW = W_US + (size_t)MS * 256 * 2;
constexpr size_t W_STA = W_CW + (size_t)NL * 512 * 32 * 4;
constexpr size_t W_STB = W_STA + (size_t)MT * 32;
constexpr size_t W_CS = W_STB + (size_t)MT * 32;
constexpr int CS_L = 13312;
constexpr size_t W_ONE = W_CS + (size_t)NL * CS_L * 4;
constexpr size_t W_CSP = W_ONE + 8192;
constexpr size_t W_RA = W_CSP + (size_t)NL * 16 * 2560 * 8;
constexpr size_t W_QH = W_RA;
constexpr size_t W_KH = W_QH + (size_t)8 * MT * 64 * 2;
constexpr size_t W_VF = W_KH + (size_t)8 * MT * 64 * 2;
constexpr size_t W_U2 = W_VF + (size_t)8 * NCHK * 4096 * 2;
constexpr size_t W_G = W_U2 + (size_t)16 * 1024 * 1152 * 2;
constexpr size_t W_MIX = W_G + (size_t)MT * 768 * 2;
constexpr size_t W_Z = W_MIX + (size_t)MT * DM * 2;
constexpr size_t W_RA_END1 = W_Z + (size_t)MT * 256 * 2;
constexpr size_t W_END = W_RA_END1;
static_assert(W_END < (size_t)1000 * 1024 * 1024, "ws budget");

constexpr int LDS_RED = 131072;
constexpr int LDS_RS = LDS_RED + 8192;
constexpr int LDS_BYTES = 131072 + 8192 + 2048 + 1024;

struct Params {
    const float* in[32];
    float* out;
    unsigned char* ws;
    int lo, hi;
};
typedef const Params __attribute__((address_space(4)))* CParams;
__device__ __forceinline__ CParams get_params() { CParams p = (CParams)__builtin_amdgcn_kernarg_segment_ptr(); asm volatile("" : "+s"(p)); return p; }
enum { I_XP = 0, I_XS, I_CK, I_CV, I_SRE, I_SIM, I_CSC, I_CFF, I_LNG, I_LNB, I_WIN, I_RELB, I_LAMRE, I_LAMIM, I_LOGDT,
       I_BRE, I_BIM, I_CRE, I_CIM, I_SD, I_WGLU, I_SCW, I_SCB, I_WOUT, I_LN1G, I_LN1B, I_WFFI, I_FCW, I_FCB, I_WFFO, I_LN2G, I_LN2B };

typedef float f32x2_t __attribute__((ext_vector_type(2))); typedef __bf16 bf16x2_t __attribute__((ext_vector_type(2)));
__device__ __forceinline__ unsigned cvt_pk_bf16(float lo, float hi) { f32x2_t v = {lo, hi}; bf16x2_t b = __builtin_convertvector(v, bf16x2_t); return __builtin_bit_cast(unsigned, b); }
__device__ __forceinline__ float bf_lo(unsigned w) { return __uint_as_float(w << 16); }
__device__ __forceinline__ float bf_hi(unsigned w) { return __uint_as_float(w & 0xffff0000u); }
__device__ __forceinline__ float bf1(bf16_t b) { return __uint_as_float(((unsigned)b) << 16); }
__device__ __forceinline__ bf16_t f2bf(float f) { return (bf16_t)(cvt_pk_bf16(f, 0.f) & 0xffffu); }
__device__ __forceinline__ u32x4 pack8(const f32x4 a, const f32x4 b) { u32x4 w; w.x = cvt_pk_bf16(a[0], a[1]); w.y = cvt_pk_bf16(a[2], a[3]); w.z = cvt_pk_bf16(b[0], b[1]); w.w = cvt_pk_bf16(b[2], b[3]); return w; }
__device__ __forceinline__ void unpack8(const u32x4 w, f32x4& a, f32x4& b) { a = (f32x4){bf_lo(w.x), bf_hi(w.x), bf_lo(w.y), bf_hi(w.y)}; b = (f32x4){bf_lo(w.z), bf_hi(w.z), bf_lo(w.w), bf_hi(w.w)}; }
__device__ __forceinline__ float fexp2(float x) { return __builtin_amdgcn_exp2f(x); }
__device__ __forceinline__ float frcp(float x) { return __builtin_amdgcn_rcpf(x); }
__device__ __forceinline__ float sigmoidf_(float a) { return frcp(1.f + fexp2(-LOG2E * a)); }
__device__ __forceinline__ float gelu_tanh(float y) { const float t = y + 0.044715f * y * y * y; return y * frcp(1.f + fexp2(-2.f * 0.7978845608028654f * LOG2E * t)); }
template <int CTRL> __device__ __forceinline__ float dpp_mov(float v) { return __int_as_float(__builtin_amdgcn_update_dpp(0, __float_as_int(v), CTRL, 0xF, 0xF, true)); }
__device__ __forceinline__ float xsum16(float v) { auto r = __builtin_amdgcn_permlane16_swap(__float_as_uint(v), __float_as_uint(v), false, false); return __uint_as_float(r[0]) + __uint_as_float(r[1]); }
__device__ __forceinline__ float xsum32(float v) { auto r = __builtin_amdgcn_permlane32_swap(__float_as_uint(v), __float_as_uint(v), false, false); return __uint_as_float(r[0]) + __uint_as_float(r[1]); }
__device__ __forceinline__ float xmax16(float v) { auto r = __builtin_amdgcn_permlane16_swap(__float_as_uint(v), __float_as_uint(v), false, false); return fmaxf(__uint_as_float(r[0]), __uint_as_float(r[1])); }
__device__ __forceinline__ float xmax32(float v) { auto r = __builtin_amdgcn_permlane32_swap(__float_as_uint(v), __float_as_uint(v), false, false); return fmaxf(__uint_as_float(r[0]), __uint_as_float(r[1])); }
__device__ __forceinline__ float wave_sum(float v) {
    v += dpp_mov<0xB1>(v); v += dpp_mov<0x4E>(v); v += dpp_mov<0x141>(v); v += dpp_mov<0x140>(v);
    return xsum32(xsum16(v));
}
__device__ __forceinline__ void cpow_exp(float lr, float li, float dt, float tau, float& er, float& ei) {
    const float mag = __expf(lr * dt * tau); const float th = (li * dt) * tau;
    const float k = rintf(th * 0.15915494309189535f);
    float r = fmaf(-k, 6.28318548202514648f, th); r = fmaf(-k, -1.7484555e-7f, r);
    const float rev = r * 0.15915494309189535f;
    const float s = __builtin_amdgcn_sinf(rev), c = __builtin_amdgcn_cosf(rev);
    er = mag * c; ei = mag * s;
}
__device__ __forceinline__ void ssm_cf(float lr, float li, float dt, float& cr, float& ci) {
    float er, ei; cpow_exp(lr, li, dt, 1.f, er, ei);
    const float nr = er - 1.f, ni = ei; const float den = frcp(lr * lr + li * li) ;
    cr = (nr * lr + ni * li) * den; ci = (ni * lr - nr * li) * den;
}

namespace pg8 {
constexpr int BM = 256, BK = 64, HALF = 128, HTB = HALF * BK * 2, NXCD = 8, WGM = 8;
__device__ __forceinline__ int lds_byte(int r, int c) { const int st = (r >> 4) * 2 + (c >> 5), rr = r & 15, cc = c & 31, ob = rr * 64 + cc * 2; return st * 1024 + (ob ^ (((ob >> 9) & 1) << 5)); }
__device__ __forceinline__ void stage_rc(int b, int& R, int& C) { const int st = b / 1024, sb = b % 1024, swz = sb ^ (((sb >> 9) & 1) << 5); R = (st >> 1) * 16 + swz / 64; C = (st & 1) * 32 + (swz % 64) / 2; }
__device__ __forceinline__ int perm32(int rho) { const int n = rho >> 4, i = rho & 15; return 8 * (i >> 2) + 4 * n + (i & 3); }

struct Unit { int pm, pn, bz; };
struct Gemm { const bf16_t* A; const bf16_t* Bt; int M, N, K, lda, ldb, batch; int ablk, nM1; unsigned off2; int kshift; };

struct Order {
    int nM, nN, nwg, total, G, c, rev;
    __device__ __forceinline__ void init(int M, int N, int batch, int G_, int c_) { nM = M / BM; nN = N / BM; nwg = nM * nN; total = nwg * batch; G = G_; c = c_; rev = 0; }
    __device__ __forceinline__ bool next(int i, Unit& u) const {
        const long L = (long)i * G + c; if (L >= total) return false;
        const int bz = (int)(L / nwg); int wgid = (int)(L % nwg);
        { const int q = nwg / NXCD, r = nwg % NXCD, xcd = wgid % NXCD; int off = wgid / NXCD; if (rev) off = (q + (xcd < r ? 1 : 0)) - 1 - off; wgid = (xcd < r ? xcd * (q + 1) : r * (q + 1) + (xcd - r) * q) + off; }
        const int nig = WGM * nN, gid = wgid / nig, fm = gid * WGM, gsz = (nM - fm) < WGM ? (nM - fm) : WGM;
        u.pm = fm + ((wgid % nig) % gsz); u.pn = (wgid % nig) / gsz; u.bz = bz; return true;
    }
};

template <class Epi>
__device__ __forceinline__ void gemm_phase(LAS unsigned char* lds, const Gemm g, const Order& S, const Epi& E, const int tid) {
    const int wid = __builtin_amdgcn_readfirstlane(tid >> 6), lane = tid & 63, wr = wid >> 2, wc = wid & 3, fr = lane & 15, fq = lane >> 4;
    const int nt = g.K / BK;
    unsigned voffA[2], voffB[2];
#pragma unroll
    for (int i = 0; i < 2; ++i) { int R, C; stage_rc(tid * 16 + i * 8192, R, C); const int Rb = (R & ~31) + perm32(R & 31);
        voffA[i] = (unsigned)((g.ablk * (R >> 6) + (R & 63)) * g.lda + C) * 2u; voffB[i] = (unsigned)(Rb * g.ldb + C) * 2u; }
    const size_t kstep = (size_t)(BK * 2);
    const unsigned hstepA = 2u * g.ablk * g.lda * 2u, hstepB = (unsigned)HALF * g.ldb * 2u;
    const unsigned tstepA = 2 * hstepA, tstepB = 2 * hstepB;
    const int nMb = g.M / BM, nNb = g.N / BM;
    const unsigned ldsw = (unsigned)wid * 1024u;
    const int aoff = lds_byte(wr * 64 + fr, fq * 8), boff = lds_byte(wc * 32 + fr, fq * 8);
#define PG8_SA(b, h) (((b) * 2 + (h)) * HTB)
#define PG8_SB(b, h) ((4 + (b) * 2 + (h)) * HTB)
#define PG8_STAGE(bufoff, gbase, voff) do { _Pragma("unroll") for (int _i = 0; _i < 2; ++_i) \
        __builtin_amdgcn_global_load_lds((const unsigned*)((const char*)(gbase) + (voff)[_i]), (LAS unsigned*)(lds + (bufoff) + ldsw + _i * 8192), 16, 0, 0); } while (0)
#define PG8_LDA(dst, b, h) do { _Pragma("unroll") for (int m = 0; m < 4; ++m) _Pragma("unroll") for (int k = 0; k < 2; ++k) dst[m][k] = *(const LAS bf16x8*)(lds + PG8_SA(b, h) + aoff + m * 2048 + k * 1024); } while (0)
#define PG8_LDB(dst, b, h) do { _Pragma("unroll") for (int n = 0; n < 2; ++n) _Pragma("unroll") for (int k = 0; k < 2; ++k) dst[n][k] = *(const LAS bf16x8*)(lds + PG8_SB(b, h) + boff + n * 2048 + k * 1024); } while (0)
#define PG8_MMA(ai, bj, At, Bt) do { __builtin_amdgcn_s_setprio(1); _Pragma("unroll") for (int m = 0; m < 4; ++m) _Pragma("unroll") for (int n = 0; n < 2; ++n) _Pragma("unroll") for (int k = 0; k < 2; ++k) \
        acc[ai][bj][m][n] = __builtin_amdgcn_mfma_f32_16x16x32_bf16(Bt[n][k], At[m][k], acc[ai][bj][m][n], 0, 0, 0); __builtin_amdgcn_s_setprio(0); } while (0)
#define PG8_WAIT_V(n) asm volatile("s_waitcnt vmcnt(" #n ")" ::: "memory")
#define PG8_WAIT_L(n) asm volatile("s_waitcnt lgkmcnt(" #n ")" ::: "memory")
#define PG8_BAR __builtin_amdgcn_s_barrier()
#define PG8_SCHED __builtin_amdgcn_sched_barrier(0)
    Unit cur, nxt; int ui = 0;
    if (!S.next(0, cur)) return;
    f32x4 acc[2][2][4][2];
#pragma unroll
    for (int a = 0; a < 2; ++a)
#pragma unroll
        for (int b = 0; b < 2; ++b)
#pragma unroll
            for (int m = 0; m < 4; ++m)
#pragma unroll
                for (int n = 0; n < 2; ++n) acc[a][b][m][n] = (f32x4){0.f, 0.f, 0.f, 0.f};
    bf16x8 At[4][2], B0[2][2], B1[2][2];
#define PG8_KOFF(u_) ((unsigned)(((u_).bz & ((1 << g.kshift) - 1)) * g.K) * 2u)
#define PG8_ABASE(u_) ((const char*)g.A + PG8_KOFF(u_) + ((u_).pm < g.nM1 ? (size_t)(((u_).bz >> g.kshift) * nMb + (u_).pm) * tstepA : (size_t)g.off2 + (size_t)((u_).pm - g.nM1) * tstepA))
#define PG8_BBASE(u_) ((const char*)g.Bt + PG8_KOFF(u_) + (size_t)(((u_).bz >> g.kshift) * nNb + (u_).pn) * tstepB)
    const char* cA = PG8_ABASE(cur);
    const char* cB = PG8_BBASE(cur);
    PG8_STAGE(PG8_SB(0, 0), cB, voffB); PG8_STAGE(PG8_SB(0, 1), cB + hstepB, voffB); PG8_STAGE(PG8_SA(0, 0), cA, voffA); PG8_STAGE(PG8_SA(0, 1), cA + hstepA, voffA);
    if (wr == 1) PG8_BAR;
    PG8_WAIT_V(2); PG8_BAR;
    PG8_STAGE(PG8_SB(1, 0), cB + kstep, voffB); PG8_STAGE(PG8_SA(1, 0), cA + kstep, voffA); PG8_STAGE(PG8_SB(1, 1), cB + hstepB + kstep, voffB);
    PG8_WAIT_V(6); PG8_BAR;
    for (;;) {
        const bool has_next = S.next(ui + 1, nxt);
        const char* nA = has_next ? PG8_ABASE(nxt) : cA;
        const char* nB = has_next ? PG8_BBASE(nxt) : cB;
        for (int t = 0; t < nt; t += 2) {
            const bool last = (t == nt - 2);
            const char* a1 = cA + (size_t)(t + 1) * kstep;
            const char* a2 = last ? nA : cA + (size_t)(t + 2) * kstep; const char* b2 = last ? nB : cB + (size_t)(t + 2) * kstep;
            const char* a3 = a2 + kstep; const char* b3 = b2 + kstep;
            PG8_LDB(B0, 0, 0); PG8_LDB(B1, 0, 1); PG8_SCHED; PG8_LDA(At, 0, 0); PG8_STAGE(PG8_SA(1, 1), a1 + hstepA, voffA);
            PG8_WAIT_V(8); PG8_WAIT_L(0); PG8_BAR; PG8_MMA(0, 0, At, B0); PG8_MMA(0, 1, At, B1); PG8_BAR; PG8_SCHED;
            PG8_LDA(At, 0, 1); PG8_STAGE(PG8_SB(0, 0), b2, voffB); PG8_STAGE(PG8_SB(0, 1), b2 + hstepB, voffB); PG8_STAGE(PG8_SA(0, 0), a2, voffA);
            PG8_WAIT_V(8); PG8_WAIT_L(0); PG8_BAR; PG8_MMA(1, 0, At, B0); PG8_MMA(1, 1, At, B1); PG8_BAR; PG8_SCHED;
            PG8_LDB(B0, 1, 0); PG8_LDB(B1, 1, 1); PG8_SCHED; PG8_LDA(At, 1, 0); PG8_STAGE(PG8_SA(0, 1), a2 + hstepA, voffA);
            PG8_WAIT_V(8); PG8_WAIT_L(0); PG8_BAR; PG8_MMA(0, 0, At, B0); PG8_MMA(0, 1, At, B1); PG8_BAR; PG8_SCHED;
            PG8_LDA(At, 1, 1); PG8_STAGE(PG8_SB(1, 0), b3, voffB); PG8_STAGE(PG8_SB(1, 1), b3 + hstepB, voffB); PG8_STAGE(PG8_SA(1, 0), a3, voffA);
            PG8_WAIT_V(8); PG8_WAIT_L(0); PG8_BAR; PG8_MMA(1, 0, At, B0); PG8_MMA(1, 1, At, B1); PG8_BAR; PG8_SCHED;
        }
        if (wr == 0) PG8_BAR;
        { int t2 = threadIdx.x; asm volatile("" : "+v"(t2));
          const int w2 = __builtin_amdgcn_readfirstlane(t2 >> 6), l2 = t2 & 63; E(acc, cur, w2 >> 2, w2 & 3, l2 & 15, l2 >> 4); }
        if (!has_next) break;
#pragma unroll
        for (int a = 0; a < 2; ++a)
#pragma unroll
            for (int b = 0; b < 2; ++b)
#pragma unroll
                for (int m = 0; m < 4; ++m)
#pragma unroll
                    for (int n = 0; n < 2; ++n) acc[a][b][m][n] = (f32x4){0.f, 0.f, 0.f, 0.f};
        cur = nxt; cA = nA; cB = nB; ++ui;
        if (wr == 1) PG8_BAR;
    }
    PG8_WAIT_V(0);
    PG8_BAR;
#undef PG8_ABASE
#undef PG8_KOFF
#undef PG8_BBASE
#undef PG8_SA
#undef PG8_SB
#undef PG8_STAGE
#undef PG8_LDA
#undef PG8_LDB
#undef PG8_MMA
#undef PG8_WAIT_V
#undef PG8_WAIT_L
#undef PG8_BAR
#undef PG8_SCHED
}
}

enum { EM_PROJ = 0, EM_HLOC, EM_YSSM, EM_GLU, EM_RES, EM_FFIN };
constexpr int NTP = 265, NTS = 3;
template <int CTRL> __device__ __forceinline__ float dppf(float old_, float src) { return __int_as_float(__builtin_amdgcn_update_dpp(__float_as_int(old_), __float_as_int(src), CTRL, 0xF, 0xF, false)); }
__device__ __forceinline__ float shift1(float cur, float prev) { return dppf<0x111>(dppf<0x121>(0.f, prev), cur); }
__device__ __forceinline__ float shift2(float cur, float prev) { return dppf<0x112>(dppf<0x122>(0.f, prev), cur); }
#define GST16(base, boff, val) (*(u32x4*)((unsigned char*)(base) + (unsigned)(boff)) = (val))
#define GSTF4(base, boff, val) (*(f32x4*)((unsigned char*)(base) + (unsigned)(boff)) = (val))
#define GST2(base, boff, val) (*(bf16_t*)((unsigned char*)(base) + (unsigned)(boff)) = (val))
#define GLD16(base, boff) (*(const u32x4*)((const unsigned char*)(base) + (unsigned)(boff)))
#define EPI_FENCE() asm volatile("" ::: "memory")
#define ROWSTAT(stb, row, mean_, rstd_) do { const f32x4 p0_ = *(const f32x4*)((stb) + (unsigned)(row) * 32u), p1_ = *(const f32x4*)((stb) + (unsigned)(row) * 32u + 16u); \
    mean_ = ((p0_[0] + p0_[2]) + (p1_[0] + p1_[2])) * (1.f / 1024.f); const float ex2_ = ((p0_[1] + p0_[3]) + (p1_[1] + p1_[3])) * (1.f / 1024.f); \
    rstd_ = __builtin_amdgcn_rsqf(ex2_ - mean_ * mean_ + LN_EPS); } while (0)
#define EPI_ROWSTATS_TO_LDS(stb) do { int t3_ = threadIdx.x; asm volatile("" : "+v"(t3_)); \
    if (t3_ < 256) { float mn_, rs_; ROWSTAT(stb, u.pm * 256 + t3_, mn_, rs_); LAS float* rsl_ = (LAS float*)(unsigned)LDS_RS; rsl_[2 * t3_] = mn_; rsl_[2 * t3_ + 1] = rs_; } \
    asm volatile("s_waitcnt lgkmcnt(0)" ::: "memory"); __builtin_amdgcn_s_barrier(); asm volatile("" ::: "memory"); } while (0)
#define EPI_RS(ai, m) (((const LAS float*)(unsigned)LDS_RS) + 2 * ((ai) * 128 + wr * 64 + (m) * 16 + fr_))
#define LN_CORRECT(cs_, bs_, colbase_) do { \
    _Pragma("unroll") for (int bj = 0; bj < 2; ++bj) _Pragma("unroll") for (int n = 0; n < 2; ++n) { const unsigned c4_ = (colbase_) + 128 * bj + 4 * n; \
        const f32x4 cc_ = *(const f32x4*)((cs_) + c4_), bb_ = *(const f32x4*)((bs_) + c4_); \
        _Pragma("unroll") for (int ai = 0; ai < 2; ++ai) _Pragma("unroll") for (int m = 0; m < 4; ++m) { const LAS float* rp_ = EPI_RS(ai, m); const float mn_ = rp_[0], rs_ = rp_[1]; \
            acc[ai][bj][m][n] = (acc[ai][bj][m][n] - cc_ * mn_) * rs_ + bb_; } } } while (0)
struct Epi {
    int mode, l;
    int sub;
    __device__ __forceinline__ void operator()(f32x4 (&acc)[2][2][4][2], const pg8::Unit& u, int wr, int wc, int fr, int fq) const {
#define EPI_COORDS() const CParams Pq = get_params(); float* const out = Pq->out; unsigned char* const ws = Pq->ws; (void)out; (void)ws; int fr_ = fr, fq_ = fq; asm volatile("" : "+v"(fr_), "+v"(fq_)); const unsigned rowb = (unsigned)(u.pm * 256 + wr * 64 + fr_); const unsigned colw = (unsigned)(wc * 32 + 8 * fq_); (void)rowb; (void)colw
        if (mode == EM_PROJ) {
            EPI_COORDS();
            const int pn = u.pn;
            {
                const float* cs = (const float*)(ws + W_CS) + l * CS_L;
                f32x4 cc_[2][2], bb_[2][2];
#pragma unroll
                for (int bj = 0; bj < 2; ++bj)
#pragma unroll
                    for (int n = 0; n < 2; ++n) { const unsigned c4_ = 256 * pn + colw + 128 * bj + 4 * n; cc_[bj][n] = *(const f32x4*)(cs + c4_); bb_[bj][n] = *(const f32x4*)(cs + 2560 + c4_); }
                EPI_ROWSTATS_TO_LDS(ws + W_STA);
#pragma unroll
                for (int ai = 0; ai < 2; ++ai)
#pragma unroll
                    for (int m = 0; m < 4; ++m) { const LAS float* rp_ = EPI_RS(ai, m); const float mn_ = rp_[0], rs_ = rp_[1];
#pragma unroll
                        for (int bj = 0; bj < 2; ++bj)
#pragma unroll
                            for (int n = 0; n < 2; ++n) acc[ai][bj][m][n] = (acc[ai][bj][m][n] - cc_[bj][n] * mn_) * rs_ + bb_[bj][n]; }
            }
            if (pn < 4) {
                const bool isk = pn >= 2; const unsigned pq = pn & 1;
                unsigned char* dst = ws + (isk ? W_KH : W_QH);
                const float sc = isk ? 1.f : 0.125f * LOG2E;
                const bool smp = u.pm >= 256; const bool tail = (u.pm & 7) >= 6;
                const unsigned d0 = 32 * (wc & 1) + 8 * fq_;
#pragma unroll
                for (int bj = 0; bj < 2; ++bj) {
                    const unsigned h = 4 * pq + 2 * bj + (wc >> 1);
                    const unsigned colk = 256 * pq + 128 * bj + colw;
#pragma unroll
                    for (int ai = 0; ai < 2; ++ai)
#pragma unroll
                        for (int m = 0; m < 4; ++m) {
                            const unsigned row = rowb + ai * 128 + m * 16;
                            const f32x4 v0 = acc[ai][bj][m][0], v1 = acc[ai][bj][m][1];
                            GST16(dst, ((h * MT + row) * 64 + d0) * 2, pack8(v0 * sc, v1 * sc));
                            if (isk) {
                                if (!smp) {
                                    if (tail) { const unsigned s = row & 2047, b = row >> 11; const unsigned o = (((l * 32 + b) * 512 + (s - 1536)) * 512 + colk) * 4;
                                        GSTF4(out + O_KP, o, v0); GSTF4(out + O_KP, o + 16, v1); }
                                } else {
                                    const unsigned ms = row - MP; const unsigned o = ((l * 512 + ms) * 512 + colk) * 4;
                                    GSTF4(out + O_KS, o, v0); GSTF4(out + O_KS, o + 16, v1);
                                    GST16(ws + W_KS, (((l * 128 + (ms >> 5) * 8 + h) * 544 + 512 + (ms & 31)) * 64 + d0) * 2, pack8(v0, v1));
                                }
                            }
                            EPI_FENCE();
                        }
                }
            } else if (pn < 6) {
                const unsigned pq = pn - 4;
                const bool smp = u.pm >= 256; const bool tail = (u.pm & 7) >= 6;
                const unsigned db = 2 * (wc & 1) + (fq_ >> 1), fqv = fr_ >> 2;
#pragma unroll
                for (int bj = 0; bj < 2; ++bj) {
                    const unsigned h = 4 * pq + 2 * bj + (wc >> 1);
                    const unsigned colk = 256 * pq + 128 * bj + colw;
#pragma unroll
                    for (int ai = 0; ai < 2; ++ai)
#pragma unroll
                        for (int m = 0; m < 4; ++m) {
                            const unsigned row = rowb + ai * 128 + m * 16;
                            const unsigned gc = 4 * u.pm + 2 * ai + wr, st = m >> 1, ii = (fr_ & 3) + 4 * (m & 1);
                            const f32x4 v0 = acc[ai][bj][m][0], v1 = acc[ai][bj][m][1];
                            const unsigned pb = ((((((h * NCHK + gc) * 2 + st) * 4 + db) * 64 + fqv * 16 + 8 * (fq_ & 1)) * 8) + ii) * 2;
#pragma unroll
                            for (int e = 0; e < 4; ++e) { GST2(ws + W_VF, pb + e * 16, f2bf(v0[e])); GST2(ws + W_VF, pb + (4 + e) * 16, f2bf(v1[e])); }
                            if (!smp) {
                                if (tail) { const unsigned s = row & 2047, b = row >> 11; const unsigned o = (((l * 32 + b) * 512 + (s - 1536)) * 512 + colk) * 4;
                                    GSTF4(out + O_VP, o, v0); GSTF4(out + O_VP, o + 16, v1); }
                            } else {
                                const unsigned ms = row - MP, t = ms & 31; const unsigned o = ((l * 512 + ms) * 512 + colk) * 4;
                                GSTF4(out + O_VS, o, v0); GSTF4(out + O_VS, o + 16, v1);
                                const unsigned i2 = (t & 3) + 4 * (t >> 4), fq2 = (t & 15) >> 2;
                                const unsigned ps = ((((((l * 128 + (ms >> 5) * 8 + h) * 18 + 16) * 4 + db) * 64 + fq2 * 16 + 8 * (fq_ & 1)) * 8) + i2) * 2;
#pragma unroll
                                for (int e = 0; e < 4; ++e) { GST2(ws + W_VFS, ps + e * 16, f2bf(v0[e])); GST2(ws + W_VFS, ps + (4 + e) * 16, f2bf(v1[e])); }
                            }
                            EPI_FENCE();
                        }
                }
            } else if (pn == 6) {
                const bool smp = u.pm >= 256;
#pragma unroll
                for (int bj = 0; bj < 2; ++bj) {
                    const unsigned col = 128 * bj + colw, g = col >> 4, ch0 = col & 15;
#pragma unroll
                    for (int ai = 0; ai < 2; ++ai)
#pragma unroll
                        for (int m = 0; m < 4; ++m) {
                            const unsigned row = rowb + ai * 128 + m * 16;
                            const u32x4 w = pack8(acc[ai][bj][m][0], acc[ai][bj][m][1]);
                            if (!smp) GST16(ws + W_U2, ((g * 1024 + (row >> 6)) * 1152 + (row & 63) * 16 + ch0) * 2, w);
                            else GST16(ws + W_US, ((row - MP) * 256 + col) * 2, w);
                            EPI_FENCE();
                        }
                }
            } else {
#pragma unroll
                for (int bj = 0; bj < 2; ++bj) {
                    const unsigned col = (pn - 7) * 256 + 128 * bj + colw;
#pragma unroll
                    for (int ai = 0; ai < 2; ++ai)
#pragma unroll
                        for (int m = 0; m < 4; ++m) {
                            const unsigned row = rowb + ai * 128 + m * 16;
                            GST16(ws + W_G, (row * 768 + col) * 2, pack8(acc[ai][bj][m][0], acc[ai][bj][m][1]));
                            EPI_FENCE();
                        }
                }
            }
        } else if (mode == EM_HLOC) {
            EPI_COORDS();
#pragma unroll
            for (int ai = 0; ai < 2; ++ai)
#pragma unroll
                for (int m = 0; m < 4; ++m) {
                    const unsigned row = rowb + ai * 128 + m * 16;
                    const unsigned o = (((((unsigned)u.bz & 3u) * 16u + ((unsigned)u.bz >> 2)) * 1024 + row) * 128 + colw) * 4;
                    GSTF4(ws + W_HLOC, o, acc[ai][0][m][0]); GSTF4(ws + W_HLOC, o + 16, acc[ai][0][m][1]);
                }
        } else if (mode == EM_YSSM) {
            EPI_COORDS();
            const unsigned g = u.bz;
            const float* dskip = Pq->in[I_SD] + l * 256;
#define Y_OFF(p_, q_, m_) (((g * 1024 + rowb + (p_) * 128 + (m_) * 16) * 1152 + 256 * u.pn + 128 * (q_) + colw) * 2)
            u32x4 buf[2][4];
#pragma unroll
            for (int m = 0; m < 4; ++m) buf[0][m] = GLD16(ws + W_U2, Y_OFF(0, 0, m));
#pragma unroll
            for (int bt = 0; bt < 4; ++bt) {
                const int bj = bt >> 1, ai = bt & 1;
                const unsigned col = 256 * u.pn + 128 * bj + colw, t = col >> 4, ch0 = col & 15;
                const f32x4 d0 = *(const f32x4*)(dskip + g * 16 + ch0), d1 = *(const f32x4*)(dskip + g * 16 + ch0 + 4);
                if (bt < 3) {
#pragma unroll
                    for (int m = 0; m < 4; ++m) buf[(bt + 1) & 1][m] = GLD16(ws + W_U2, Y_OFF((bt + 1) & 1, (bt + 1) >> 1, m));
                }
                EPI_FENCE();
#pragma unroll
                for (int m = 0; m < 4; ++m) {
                    const unsigned row = rowb + ai * 128 + m * 16;
                    f32x4 u0, u1; unpack8(buf[bt & 1][m], u0, u1);
                    f32x4 y0 = acc[ai][bj][m][0] + d0 * u0, y1 = acc[ai][bj][m][1] + d1 * u1;
#pragma unroll
                    for (int e = 0; e < 4; ++e) { y0[e] = gelu_tanh(y0[e]); y1[e] = gelu_tanh(y1[e]); }
                    GST16(ws + W_Z, ((row * 64 + t) * 256 + g * 16 + ch0) * 2, pack8(y0, y1));
                }
                EPI_FENCE();
            }
#undef Y_OFF
        } else if (mode == EM_GLU) {
            EPI_COORDS();
#define Z_OFF(p_, q_, m_) (((rowb + (p_) * 128 + (m_) * 16) * 256 + 128 * (q_) + colw) * 2)
            u32x4 buf[2][4];
#pragma unroll
            for (int m = 0; m < 4; ++m) buf[0][m] = GLD16(ws + W_Z, Z_OFF(0, 0, m));
#pragma unroll
            for (int bt = 0; bt < 4; ++bt) {
                const int bj = bt >> 1, ai = bt & 1;
                if (bt < 3) {
#pragma unroll
                    for (int m = 0; m < 4; ++m) buf[(bt + 1) & 1][m] = GLD16(ws + W_Z, Z_OFF((bt + 1) & 1, (bt + 1) >> 1, m));
                }
                EPI_FENCE();
#pragma unroll
                for (int m = 0; m < 4; ++m) {
                    const unsigned row = rowb + ai * 128 + m * 16;
                    f32x4 z0, z1; unpack8(buf[bt & 1][m], z0, z1);
                    f32x4 a0 = acc[ai][bj][m][0], a1 = acc[ai][bj][m][1];
#pragma unroll
                    for (int e = 0; e < 4; ++e) { a0[e] = z0[e] * sigmoidf_(a0[e]); a1[e] = z1[e] * sigmoidf_(a1[e]); }
                    GST16(ws + W_MIX, (row * 1024 + 512 + 128 * bj + colw) * 2, pack8(a0, a1));
                }
                EPI_FENCE();
            }
#undef Z_OFF
        } else if (mode == EM_RES) {
            EPI_COORDS();
#define RES_OFF(p_, q_, m_) (((rowb + (p_) * 128 + (m_) * 16) * 1024 + 256 * u.pn + 128 * (q_) + colw) * 2)
            if (sub == 0) {
                const float* gp = l ? Pq->in[I_LN2G] + (l - 1) * 1024 : (const float*)(ws + W_ONE);
                const float* bp = l ? Pq->in[I_LN2B] + (l - 1) * 1024 : (const float*)(ws + W_ONE) + 1024;
                u32x4 buf[2][4];
#pragma unroll
                for (int m = 0; m < 4; ++m) buf[0][m] = GLD16(ws + W_XV, RES_OFF(0, 0, m));
                EPI_ROWSTATS_TO_LDS(ws + W_STA);
#pragma unroll
                for (int bt = 0; bt < 4; ++bt) {
                    const int bj = bt >> 1, ai = bt & 1;
                    const unsigned col = 256 * u.pn + 128 * bj + colw;
                    const f32x4 g0 = *(const f32x4*)(gp + col), g1 = *(const f32x4*)(gp + col + 4), b0 = *(const f32x4*)(bp + col), b1 = *(const f32x4*)(bp + col + 4);
                    if (bt < 3) {
#pragma unroll
                        for (int m = 0; m < 4; ++m) buf[(bt + 1) & 1][m] = GLD16(ws + W_XV, RES_OFF((bt + 1) & 1, (bt + 1) >> 1, m));
                    }
                    EPI_FENCE();
#pragma unroll
                    for (int m = 0; m < 4; ++m) {
                        const LAS float* rp = EPI_RS(ai, m); const float mn = rp[0], rs = rp[1];
                        f32x4 x0, x1; unpack8(buf[bt & 1][m], x0, x1);
                        x0 = (x0 - mn) * rs * g0 + b0; x1 = (x1 - mn) * rs * g1 + b1;
                        GST16(ws + W_XV, RES_OFF(ai, bj, m), pack8(x0 * ALPHA + acc[ai][bj][m][0], x1 * ALPHA + acc[ai][bj][m][1]));
                    }
                    EPI_FENCE();
                }
            } else {
                LAS float* red = (LAS float*)(unsigned)LDS_RED;
                u32x4 buf[2][4]; float s1[4], s2[4];
#pragma unroll
                for (int m = 0; m < 4; ++m) buf[0][m] = GLD16(ws + W_XV, RES_OFF(0, 0, m));
#pragma unroll
                for (int bt = 0; bt < 4; ++bt) {
                    const int ai = bt >> 1, bj = bt & 1;
                    if (bt < 3) {
#pragma unroll
                        for (int m = 0; m < 4; ++m) buf[(bt + 1) & 1][m] = GLD16(ws + W_XV, RES_OFF((bt + 1) >> 1, (bt + 1) & 1, m));
                    }
                    EPI_FENCE();
#pragma unroll
                    for (int m = 0; m < 4; ++m) {
                        f32x4 x0, x1; unpack8(buf[bt & 1][m], x0, x1);
                        const u32x4 w = pack8(x0 * ALPHA + acc[ai][bj][m][0], x1 * ALPHA + acc[ai][bj][m][1]);
                        GST16(ws + W_XV, RES_OFF(ai, bj, m), w);
                        f32x4 r0, r1; unpack8(w, r0, r1);
                        const float a = ((r0[0] + r0[1]) + (r0[2] + r0[3])) + ((r1[0] + r1[1]) + (r1[2] + r1[3]));
                        const float b = ((r0[0] * r0[0] + r0[1] * r0[1]) + (r0[2] * r0[2] + r0[3] * r0[3])) + ((r1[0] * r1[0] + r1[1] * r1[1]) + (r1[2] * r1[2] + r1[3] * r1[3]));
                        if (bj == 0) { s1[m] = a; s2[m] = b; } else { s1[m] += a; s2[m] += b; }
                    }
                    if (bj == 1) {
#pragma unroll
                        for (int m = 0; m < 4; ++m) {
                            float a = s1[m], b = s2[m];
                            a = xsum32(xsum16(a)); b = xsum32(xsum16(b));
                            if (fq_ == 0) { const int ri = wc * 256 + ai * 128 + wr * 64 + m * 16 + fr_; red[2 * ri] = a; red[2 * ri + 1] = b; }
                        }
                    }
                    EPI_FENCE();
                }
                asm volatile("s_waitcnt lgkmcnt(0)" ::: "memory"); __builtin_amdgcn_s_barrier(); asm volatile("" ::: "memory");
                { int t3 = threadIdx.x; asm volatile("" : "+v"(t3));
                  if (t3 < 256) { float a = 0.f, b = 0.f;
#pragma unroll
                      for (int q = 0; q < 4; ++q) { a += red[2 * (q * 256 + t3)]; b += red[2 * (q * 256 + t3) + 1]; }
                      typedef float f32x2v __attribute__((ext_vector_type(2)));
                      *(f32x2v*)(ws + W_STA + ((unsigned)(u.pm * 256 + t3) * 4u + u.pn) * 8u) = (f32x2v){a, b}; } }
            }
#undef RES_OFF
        } else {
            EPI_COORDS();
            const bool smp = u.pm >= NTP;
            const int R0t = smp ? (MP + 248 * (u.pm - NTP) - 2) : (248 * u.pm - 2);
            const int lim = smp ? MT : MP;
            const float* cachef = Pq->in[I_CFF];
            {
                int t3_ = threadIdx.x; asm volatile("" : "+v"(t3_));
                if (t3_ < 256) *(LAS f32x4*)(unsigned)(LDS_RED + t3_ * 16) = *(const f32x4*)(ws + W_CW + (unsigned)((l * 512 + 32 * u.pn) * 128 + t3_ * 16));
                asm volatile("s_waitcnt vmcnt(0) lgkmcnt(0)" ::: "memory"); __builtin_amdgcn_s_barrier(); asm volatile("" ::: "memory");
            }
#pragma unroll
            for (int n = 0; n < 2; ++n) {
                EPI_FENCE();
                const unsigned f0 = 128 * u.pn + colw + 4 * n;
                const LAS f32x4* cwp = (const LAS f32x4*)(unsigned)(LDS_RED + (8 * wc + 2 * fq_ + n) * 128);
                const f32x4 wg0 = cwp[0], wg1 = cwp[1], wg2 = cwp[2], wv0 = cwp[3], wv1 = cwp[4], wv2 = cwp[5], bg = cwp[6], bv = cwp[7];
#pragma unroll
                for (int ai = 0; ai < 2; ++ai) {
                    const int Rb = R0t + 62 * (2 * ai + wr);
#pragma unroll
                    for (int m = 0; m < 4; ++m) {
                        const int w = 16 * m + fr_, R = Rb + w;
                        const f32x4 g0 = acc[ai][0][m][n], v0 = acc[ai][1][m][n];
                        const f32x4 gp = acc[ai][0][m ? m - 1 : 0][n], vp = acc[ai][1][m ? m - 1 : 0][n];
                        f32x4 g1, g2, v1, v2;
#pragma unroll
                        for (int e = 0; e < 4; ++e) { g1[e] = shift1(g0[e], gp[e]); g2[e] = shift2(g0[e], gp[e]); v1[e] = shift1(v0[e], vp[e]); v2[e] = shift2(v0[e], vp[e]); }
                        const bool ok = (w >= 2) && (R < lim);
                        if (!smp) {
                            const int sq = R & 2047;
                            if (sq == 0) { g1 = (f32x4){0.f, 0.f, 0.f, 0.f}; v1 = g1; }
                            if (sq <= 1) { g2 = (f32x4){0.f, 0.f, 0.f, 0.f}; v2 = g2; }
                        } else if (ok) {
                            const int t = (R - MP) & 31, b = (R - MP) >> 5;
                            if (t <= 1) {
                                const float* c1 = cachef + ((size_t)(l * 16 + b) * 2 + 1) * 4096 + f0;
                                const f32x4 cg = *(const f32x4*)c1, cv = *(const f32x4*)(c1 + 2048);
                                if (t == 0) { g1 = cg; v1 = cv; g2 = *(const f32x4*)(c1 - 4096); v2 = *(const f32x4*)(c1 - 4096 + 2048); }
                                else { g2 = cg; v2 = cv; }
                            }
                        }
                        const f32x4 gg = wg0 * g2 + wg1 * g1 + wg2 * g0 + bg, vv = wv0 * v2 + wv1 * v1 + wv2 * v0 + bv;
                        f32x4 h;
#pragma unroll
                        for (int e = 0; e < 4; ++e) h[e] = gg[e] * sigmoidf_(gg[e]) * vv[e];
                        if (ok) {
                            u32x2 hw; hw.x = cvt_pk_bf16(h[0], h[1]); hw.y = cvt_pk_bf16(h[2], h[3]);
                            *(u32x2*)((unsigned char*)out + ((unsigned)R * 2048u + f0) * 2u) = hw;
                            if (!smp) {
                                const int sq = R & 2047;
                                if (sq >= 2046) { const unsigned o = (((l * 32 + (R >> 11)) * 2 + (sq - 2046)) * 4096 + f0) * 4; GSTF4(out + O_FFP, o, g0); GSTF4(out + O_FFP, o + 8192, v0); }
                            } else {
                                const int t = (R - MP) & 31, b = (R - MP) >> 5;
                                if (t >= 30) { const unsigned o = (((l * 16 + b) * 2 + (t - 30)) * 4096 + f0) * 4; GSTF4(out + O_FFS, o, g0); GSTF4(out + O_FFS, o + 8192, v0); }
                            }
                        }
                        EPI_FENCE();
                    }
                }
            }
        }
    }
};

struct Ctx { int tid, lane, wave, G, bid, gtid, NT, gw, NGW; };

__device__ __forceinline__ int ffperm(int n) { return n < 2048 ? ((n >> 7) << 8) + (n & 127) : (((n - 2048) >> 7) << 8) + 128 + ((n - 2048) & 127); }
__device__ __forceinline__ void transpose_item(const float* W, int K, int N, bf16_t* WT, LAS float* scr, int item, int lane, bool ffp = false, const float* gk = nullptr) {
    const int nblk = N / 32, kb = item / nblk, nb = item % nblk, k0 = 64 * kb, n0 = 32 * nb;
#pragma unroll 8
    for (int i = 0; i < 32; ++i) { const int kk = 2 * i + (lane >> 5); float wv = W[(size_t)(k0 + kk) * N + n0 + (lane & 31)]; if (gk) wv *= gk[k0 + kk]; scr[kk * 33 + (lane & 31)] = wv; }
    asm volatile("s_waitcnt lgkmcnt(0)" ::: "memory");
    const int c = lane & 7;
#pragma unroll
    for (int j = 0; j < 4; ++j) { const int n = (lane >> 3) + 8 * j; const LAS float* s = scr + (8 * c) * 33 + n;
        u32x4 o; o.x = cvt_pk_bf16(s[0 * 33], s[1 * 33]); o.y = cvt_pk_bf16(s[2 * 33], s[3 * 33]); o.z = cvt_pk_bf16(s[4 * 33], s[5 * 33]); o.w = cvt_pk_bf16(s[6 * 33], s[7 * 33]);
        const int nd = ffp ? ffperm(n0 + n) : (n0 + n);
        *(u32x4*)(WT + (size_t)nd * K + k0 + 8 * c) = o; }
    asm volatile("s_waitcnt lgkmcnt(0)" ::: "memory");
}

__device__ __forceinline__ void ln_in_load(const float* xrow, f32x4 (&v)[4], int lane) {
#pragma unroll
    for (int j = 0; j < 2; ++j) { v[2 * j] = *(const f32x4*)(xrow + lane * 8 + 512 * j); v[2 * j + 1] = *(const f32x4*)(xrow + lane * 8 + 512 * j + 4); }
}
__device__ __forceinline__ void ln_in_compute(f32x4 (&v)[4], const float* g, const float* b, bf16_t* orow, int lane) {
    float s = 0.f;
#pragma unroll
    for (int j = 0; j < 4; ++j) s += (v[j][0] + v[j][1]) + (v[j][2] + v[j][3]);
    const float mean = wave_sum(s) * (1.f / 1024.f); float q = 0.f;
#pragma unroll
    for (int j = 0; j < 4; ++j) { v[j] = v[j] - mean; q += (v[j][0] * v[j][0] + v[j][1] * v[j][1]) + (v[j][2] * v[j][2] + v[j][3] * v[j][3]); }
    const float rstd = 1.f / sqrtf(wave_sum(q) * (1.f / 1024.f) + LN_EPS);
#pragma unroll
    for (int j = 0; j < 2; ++j) {
        const int c = lane * 8 + 512 * j;
        const f32x4 g0 = *(const f32x4*)(g + c), g1 = *(const f32x4*)(g + c + 4), b0 = *(const f32x4*)(b + c), b1 = *(const f32x4*)(b + c + 4);
        *(u32x4*)(orow + c) = pack8(v[2 * j] * rstd * g0 + b0, v[2 * j + 1] * rstd * g1 + b1);
    }
}

__device__ __forceinline__ void ln_phase(const Ctx& C, unsigned char* ws, const float* g, const float* b, float* yout) {
    bf16_t* xv = (bf16_t*)(ws + W_XV);
    f32x4 gg[4], bb[4];
#pragma unroll
    for (int j = 0; j < 2; ++j) { const int c = C.lane * 8 + 512 * j; gg[2 * j] = *(const f32x4*)(g + c); gg[2 * j + 1] = *(const f32x4*)(g + c + 4); bb[2 * j] = *(const f32x4*)(b + c); bb[2 * j + 1] = *(const f32x4*)(b + c + 4); }
    for (int row0 = C.gw; row0 < MT; row0 += 4 * C.NGW) {
        u32x4 w[4][2];
#pragma unroll
        for (int k = 0; k < 4; ++k) { const int row = row0 + k * C.NGW;
            if (row < MT) {
#pragma unroll
                for (int j = 0; j < 2; ++j) w[k][j] = *(const u32x4*)(xv + (size_t)row * 1024 + C.lane * 8 + 512 * j);
            } else { w[k][0] = (u32x4){0u, 0u, 0u, 0u}; w[k][1] = w[k][0]; } }
#pragma unroll
        for (int k = 0; k < 4; ++k) { const int row = row0 + k * C.NGW;
            if (row < MT) {
                bf16_t* xr = xv + (size_t)row * 1024;
                f32x4 v[4]; float s = 0.f;
#pragma unroll
                for (int j = 0; j < 2; ++j) unpack8(w[k][j], v[2 * j], v[2 * j + 1]);
#pragma unroll
                for (int j = 0; j < 4; ++j) s += (v[j][0] + v[j][1]) + (v[j][2] + v[j][3]);
                const float mean = wave_sum(s) * (1.f / 1024.f); float q = 0.f;
#pragma unroll
                for (int j = 0; j < 4; ++j) { v[j] = v[j] - mean; q += (v[j][0] * v[j][0] + v[j][1] * v[j][1]) + (v[j][2] * v[j][2] + v[j][3] * v[j][3]); }
                const float rstd = 1.f / sqrtf(wave_sum(q) * (1.f / 1024.f) + LN_EPS);
#pragma unroll
                for (int j = 0; j < 4; ++j) v[j] = v[j] * rstd * gg[j] + bb[j];
#pragma unroll
                for (int j = 0; j < 2; ++j) *(u32x4*)(xr + C.lane * 8 + 512 * j) = pack8(v[2 * j], v[2 * j + 1]);
                if (yout) {
#pragma unroll
                    for (int j = 0; j < 2; ++j) { float* p = yout + (size_t)row * 1024 + C.lane * 8 + 512 * j; *(f32x4*)p = v[2 * j]; *(f32x4*)(p + 4) = v[2 * j + 1]; }
                }
            } }
    }
}

__device__ __forceinline__ void ssm_T_phase(const Ctx& C, int l, LAS unsigned char* lds) {
    const CParams Pp = get_params();
    LAS float* Wr = (LAS float*)lds; LAS float* Wi = Wr + 64 * 17;
    float* T = (float*)(Pp->ws + W_SSMT);
    for (int unit = C.bid; unit < 1024; unit += C.G) {
        const int g = unit >> 6, tau = unit & 63;
        const int p = C.tid >> 3, c2 = (C.tid & 7) * 2;
        const float lr = Pp->in[I_LAMRE][(l * 16 + g) * 64 + p], li = Pp->in[I_LAMIM][(l * 16 + g) * 64 + p], dt = __expf(Pp->in[I_LOGDT][l * 16 + g]);
        float er, ei, cr, ci; cpow_exp(lr, li, dt, (float)tau, er, ei); ssm_cf(lr, li, dt, cr, ci);
        const float fr_ = er * cr - ei * ci, fi_ = er * ci + ei * cr;
#pragma unroll
        for (int k = 0; k < 2; ++k) {
            const size_t bi = ((size_t)(l * 16 + g) * 64 + p) * 16 + c2 + k;
            const float br = Pp->in[I_BRE][bi], bim = Pp->in[I_BIM][bi];
            Wr[p * 17 + c2 + k] = fr_ * br - fi_ * bim; Wi[p * 17 + c2 + k] = fr_ * bim + fi_ * br;
        }
        __syncthreads();
        if (C.tid < 256) {
            const int co = C.tid >> 4, ci2 = C.tid & 15;
            const float* cre = Pp->in[I_CRE] + ((size_t)(l * 16 + g) * 16 + co) * 64; const float* cim = Pp->in[I_CIM] + ((size_t)(l * 16 + g) * 16 + co) * 64;
            float a = 0.f;
            for (int pp = 0; pp < 64; ++pp) a += cre[pp] * Wr[pp * 17 + ci2] - cim[pp] * Wi[pp * 17 + ci2];
            T[((size_t)(g * 64 + tau) * 16 + co) * 16 + ci2] = a;
        }
        __syncthreads();
    }
}

__device__ __forceinline__ void ssm_fill_phase(const Ctx& C, int l) {
    const CParams Pp = get_params();
    const float* T = (const float*)(Pp->ws + W_SSMT);
    bf16_t* YK = (bf16_t*)(Pp->ws + W_YK); bf16_t* HM = (bf16_t*)(Pp->ws + W_HM);
    for (int item = C.gtid; item < 16 * 1024 * 128; item += C.NT) {
        const int half = item & 1, s = (item >> 1) & 63, rowi = item >> 7, g = rowi >> 10, t = (rowi >> 4) & 63, co = rowi & 15;
        u32x4 w = (u32x4){0u, 0u, 0u, 0u};
        if (s <= t) { const float* tp = T + ((size_t)(g * 64 + (t - s)) * 16 + co) * 16 + half * 8; w = pack8(*(const f32x4*)tp, *(const f32x4*)(tp + 4)); }
        *(u32x4*)(YK + (size_t)rowi * 1152 + s * 16 + half * 8) = w;
    }
    for (int item = C.gtid; item < 16 * 1024 * 64; item += C.NT) {
        const int p = item & 63, rowi = item >> 6, g = rowi >> 10, t = (rowi >> 4) & 63, co = rowi & 15;
        const float lr = Pp->in[I_LAMRE][(l * 16 + g) * 64 + p], li = Pp->in[I_LAMIM][(l * 16 + g) * 64 + p], dt = __expf(Pp->in[I_LOGDT][l * 16 + g]);
        float er, ei; cpow_exp(lr, li, dt, (float)(t + 1), er, ei);
        const size_t ci_ = ((size_t)(l * 16 + g) * 16 + co) * 64 + p;
        const float cr = Pp->in[I_CRE][ci_], ci = Pp->in[I_CIM][ci_];
        YK[(size_t)rowi * 1152 + 1024 + p] = f2bf(cr * er - ci * ei);
        YK[(size_t)rowi * 1152 + 1088 + p] = f2bf(-(cr * ei + ci * er));
    }
    for (int item = C.gtid; item < 16 * 128 * 64; item += C.NT) {
        const int s = item & 63, pr = (item >> 6) & 127, g = item >> 13, p = pr & 63, part = pr >> 6;
        const float lr = Pp->in[I_LAMRE][(l * 16 + g) * 64 + p], li = Pp->in[I_LAMIM][(l * 16 + g) * 64 + p], dt = __expf(Pp->in[I_LOGDT][l * 16 + g]);
        float er, ei, cr, ci; cpow_exp(lr, li, dt, (float)(63 - s), er, ei); ssm_cf(lr, li, dt, cr, ci);
        const float fr_ = er * cr - ei * ci, fi_ = er * ci + ei * cr;
        const float* br = Pp->in[I_BRE] + ((size_t)(l * 16 + g) * 64 + p) * 16; const float* bi = Pp->in[I_BIM] + ((size_t)(l * 16 + g) * 64 + p) * 16;
        f32x4 o[4];
#pragma unroll
        for (int q = 0; q < 4; ++q) {
            const f32x4 b_r = *(const f32x4*)(br + 4 * q), b_i = *(const f32x4*)(bi + 4 * q);
            o[q] = part ? (b_i * fr_ + b_r * fi_) : (b_r * fr_ - b_i * fi_);
        }
        bf16_t* dst = HM + ((size_t)g * 256 + pr) * 1024 + s * 16;
        *(u32x4*)dst = pack8(o[0], o[1]); *(u32x4*)(dst + 8) = pack8(o[2], o[3]);
    }
    for (int item = C.gtid; item < 16 * 128 * 128; item += C.NT) {
        const int c8 = item & 127, r = (item >> 7) & 127, g = item >> 14;
        *(u32x4*)(HM + ((size_t)g * 256 + 128 + r) * 1024 + c8 * 8) = (u32x4){0u, 0u, 0u, 0u};
    }
}

__device__ __forceinline__ void convert_layer(const Ctx& C, LAS unsigned char* lds, int l) {
    const CParams Pp = get_params();
    LAS float* scr = (LAS float*)(lds + C.wave * 16384);
    constexpr int I_A = 16 * 80, I_B = 16 * 32, I_C = 16 * 128, I_D = 32 * 32, I_E = 4 * 8, I_L = I_A + I_B + I_C + I_D + I_E;
    for (int it = C.gw; it < I_L; it += C.NGW) {
        int r = it;
        if (r < I_A) { transpose_item(Pp->in[I_WIN] + (size_t)l * DM * NPROJ, DM, NPROJ, (bf16_t*)(Pp->ws + W_WIN) + (size_t)l * NPROJ * DM, scr, r, C.lane, false, l ? Pp->in[I_LN2G] + (l - 1) * 1024 : nullptr); continue; } r -= I_A;
        if (r < I_B) { transpose_item(Pp->in[I_WOUT] + (size_t)l * DM * DM, DM, DM, (bf16_t*)(Pp->ws + W_WOUT) + (size_t)l * DM * DM, scr, r, C.lane); continue; } r -= I_B;
        if (r < I_C) { transpose_item(Pp->in[I_WFFI] + (size_t)l * DM * DFF2, DM, DFF2, (bf16_t*)(Pp->ws + W_WFFI) + (size_t)l * DFF2 * DM, scr, r, C.lane, true); continue; } r -= I_C;
        if (r < I_D) { transpose_item(Pp->in[I_WFFO] + (size_t)l * DFF * DM, DFF, DM, (bf16_t*)(Pp->ws + W_WFFO) + (size_t)l * DM * DFF, scr, r, C.lane); continue; } r -= I_D;
        transpose_item(Pp->in[I_WGLU] + (size_t)l * 65536, 256, 256, (bf16_t*)(Pp->ws + W_WGLU) + (size_t)l * 65536, scr, r, C.lane);
    }
    for (int item = C.gtid; item < 16 * 512 * 8 * 8; item += C.NT) {
        const int d8 = item & 7, h = (item >> 3) & 7, j = (item >> 6) & 511, b = (item >> 15) & 15;
        const float* src = Pp->in[I_CK] + ((((size_t)(l * 16 + b) * 512 + j) * 8 + h) * 64 + d8 * 8);
        *(u32x4*)((bf16_t*)(Pp->ws + W_KS) + ((size_t)(l * 128 + b * 8 + h) * 544 + j) * 64 + d8 * 8) = pack8(*(const f32x4*)src, *(const f32x4*)(src + 4));
    }
    for (int item = C.gtid; item < 128 * 16 * 4 * 64; item += C.NT) {
        const int ln = item & 63, db = (item >> 6) & 3, st = (item >> 8) & 15, bh = (item >> 12) & 127;
        const int frv = ln & 15, fqv = ln >> 4, d = 16 * db + frv, b = bh >> 3, h = bh & 7;
        float v[8];
#pragma unroll
        for (int i = 0; i < 8; ++i) { const int key = 32 * st + (i < 4 ? 4 * fqv + i : 16 + 4 * fqv + i - 4);
            v[i] = Pp->in[I_CV][(((size_t)(l * 16 + b) * 512 + key) * 8 + h) * 64 + d]; }
        u32x4 w; w.x = cvt_pk_bf16(v[0], v[1]); w.y = cvt_pk_bf16(v[2], v[3]); w.z = cvt_pk_bf16(v[4], v[5]); w.w = cvt_pk_bf16(v[6], v[7]);
        *(u32x4*)((bf16_t*)(Pp->ws + W_VFS) + ((((size_t)(l * 128 + bh) * 18 + st) * 4 + db) * 64 + ln) * 8) = w;
    }
}

__device__ __forceinline__ void prologue_phase(const Ctx& C, LAS unsigned char* lds) {
    const CParams Pp = get_params();
    const int nconv = (C.G > 8) ? 1 : NL;
    for (int l = 0; l < nconv; ++l) convert_layer(C, lds, l);
    for (int item = C.gtid; item < NL * 512 * 8; item += C.NT) {
        const int j = item & 7, grp = (item >> 3) & 511, l = item >> 12;
        const float* src = j < 3 ? Pp->in[I_FCW] + (size_t)(l * 3 + j) * 4096 + grp * 4 : j < 6 ? Pp->in[I_FCW] + (size_t)(l * 3 + j - 3) * 4096 + 2048 + grp * 4
                         : j == 6 ? Pp->in[I_FCB] + (size_t)l * 4096 + grp * 4 : Pp->in[I_FCB] + (size_t)l * 4096 + 2048 + grp * 4;
        *(f32x4*)(Pp->ws + W_CW + (size_t)item * 16) = *(const f32x4*)src;
    }
    for (int item = C.gtid; item < NL * 2560 * 16; item += C.NT) {
        const int n = item % 2560, kc = (item / 2560) & 15, l = item / (2560 * 16);
        const float* W = Pp->in[I_WIN] + (size_t)l * DM * NPROJ + (size_t)kc * 64 * NPROJ + n;
        const float* gk = Pp->in[I_LN2G] + (l ? l - 1 : 0) * 1024 + kc * 64;
        const float* bk = Pp->in[I_LN2B] + (l ? l - 1 : 0) * 1024 + kc * 64;
        float cs = 0.f, bs = 0.f;
#pragma unroll 16
        for (int k = 0; k < 64; ++k) { const float w = W[(size_t)k * NPROJ]; const float wf = l ? w * gk[k] : w; cs += bf1(f2bf(wf)); bs += l ? bk[k] * w : 0.f; }
        float* dst = (float*)(Pp->ws + W_CSP) + (size_t)item * 2;
        dst[0] = cs; dst[1] = bs;
    }
    for (int item = C.gtid; item < MT * 4; item += C.NT) { typedef float f32x2v __attribute__((ext_vector_type(2))); *(f32x2v*)(Pp->ws + W_STA + (size_t)item * 8) = (f32x2v){0.f, 256.f * (1.f - LN_EPS)}; }
    for (int item = C.gtid; item < 2048; item += C.NT) ((float*)(Pp->ws + W_ONE))[item] = item < 1024 ? 1.f : 0.f;
    for (int row0 = C.gw; row0 < MT; row0 += 3 * C.NGW) {
        f32x4 va[4], vb[4], vc[4];
        const int r1 = row0 + C.NGW, r2 = row0 + 2 * C.NGW;
        ln_in_load(row0 < MP ? Pp->in[I_XP] + (size_t)row0 * 1024 : Pp->in[I_XS] + (size_t)(row0 - MP) * 1024, va, C.lane);
        if (r1 < MT) ln_in_load(r1 < MP ? Pp->in[I_XP] + (size_t)r1 * 1024 : Pp->in[I_XS] + (size_t)(r1 - MP) * 1024, vb, C.lane);
        if (r2 < MT) ln_in_load(r2 < MP ? Pp->in[I_XP] + (size_t)r2 * 1024 : Pp->in[I_XS] + (size_t)(r2 - MP) * 1024, vc, C.lane);
        ln_in_compute(va, Pp->in[I_LNG], Pp->in[I_LNB], (bf16_t*)(Pp->ws + W_XV) + (size_t)row0 * 1024, C.lane);
        if (r1 < MT) ln_in_compute(vb, Pp->in[I_LNG], Pp->in[I_LNB], (bf16_t*)(Pp->ws + W_XV) + (size_t)r1 * 1024, C.lane);
        if (r2 < MT) ln_in_compute(vc, Pp->in[I_LNG], Pp->in[I_LNB], (bf16_t*)(Pp->ws + W_XV) + (size_t)r2 * 1024, C.lane);
    }
}

__device__ __forceinline__ void attn_unit(const bf16_t* __restrict__ Q, const bf16_t* __restrict__ K, const bf16_t* __restrict__ VFp,
                                          int nsteps, int dist0, const LAS float* bias, bf16_t* out, int nqb, int lane) {
    const int fr = lane & 15, fq = lane >> 4;
    bf16x8 qf[4][2];
#pragma unroll
    for (int qb = 0; qb < 4; ++qb)
#pragma unroll
        for (int ds = 0; ds < 2; ++ds) {
            if (qb < nqb) qf[qb][ds] = *(const bf16x8*)(Q + (size_t)(16 * qb + fr) * 64 + 32 * ds + 8 * fq);
            else qf[qb][ds] = (bf16x8){0, 0, 0, 0, 0, 0, 0, 0};
        }
    f32x4 o[4][4]; float mrow[4], lrow[4];
#pragma unroll
    for (int a = 0; a < 4; ++a) { mrow[a] = -1e30f; lrow[a] = 0.f;
#pragma unroll
        for (int b = 0; b < 4; ++b) o[a][b] = (f32x4){0.f, 0.f, 0.f, 0.f}; }
    bf16x8 kf[2][2];
    {
        const bf16_t* kp = K + (size_t)fr * 64 + 8 * fq;
#pragma unroll
        for (int kb = 0; kb < 2; ++kb)
#pragma unroll
            for (int ds = 0; ds < 2; ++ds) kf[kb][ds] = *(const bf16x8*)(kp + kb * 1024 + ds * 32);
    }
    const float bfar = bias[191];
    for (int st = 0; st < nsteps; ++st) {
        bf16x8 kn[2][2], vf[4];
        const bf16_t* vp = VFp + (size_t)st * 2048 + lane * 8;
#pragma unroll
        for (int db = 0; db < 4; ++db) vf[db] = *(const bf16x8*)(vp + db * 512);
        if (st + 1 < nsteps) {
            const bf16_t* kp = K + (size_t)(32 * (st + 1) + fr) * 64 + 8 * fq;
#pragma unroll
            for (int kb = 0; kb < 2; ++kb)
#pragma unroll
                for (int ds = 0; ds < 2; ++ds) kn[kb][ds] = *(const bf16x8*)(kp + kb * 1024 + ds * 32);
        } else {
#pragma unroll
            for (int kb = 0; kb < 2; ++kb)
#pragma unroll
                for (int ds = 0; ds < 2; ++ds) kn[kb][ds] = kf[kb][ds];
        }
        f32x4 s[2][4];
#pragma unroll
        for (int kb = 0; kb < 2; ++kb)
#pragma unroll
            for (int qb = 0; qb < 4; ++qb) {
                s[kb][qb] = __builtin_amdgcn_mfma_f32_16x16x32_bf16(kf[kb][0], qf[qb][0], (f32x4){0.f, 0.f, 0.f, 0.f}, 0, 0, 0);
                s[kb][qb] = __builtin_amdgcn_mfma_f32_16x16x32_bf16(kf[kb][1], qf[qb][1], s[kb][qb], 0, 0, 0);
            }
        const int dbase = dist0 + fr - 32 * st - 4 * fq;
        const bool far = (dist0 - 32 * st - 31) >= 128;
#pragma unroll
        for (int qb = 0; qb < 4; ++qb) {
            float mx = -1e30f;
            if (far) {
#pragma unroll
                for (int kb = 0; kb < 2; ++kb)
#pragma unroll
                    for (int r = 0; r < 4; ++r) { const float v = s[kb][qb][r] + bfar; s[kb][qb][r] = v; mx = fmaxf(mx, v); }
            } else {
#pragma unroll
                for (int kb = 0; kb < 2; ++kb)
#pragma unroll
                    for (int r = 0; r < 4; ++r) {
                        int d = dbase + 16 * qb - 16 * kb - r; d = d < -63 ? -63 : d; d = d > 128 ? 128 : d;
                        const float v = s[kb][qb][r] + bias[d + 63]; s[kb][qb][r] = v; mx = fmaxf(mx, v);
                    }
            }
            mx = xmax32(xmax16(mx));
            if (__any(mx > mrow[qb])) {
                const float mnew = fmaxf(mrow[qb], mx), al = fexp2(mrow[qb] - mnew); mrow[qb] = mnew; lrow[qb] *= al;
#pragma unroll
                for (int db = 0; db < 4; ++db) o[db][qb] = o[db][qb] * al;
            }
            const float mcur = mrow[qb];
            float ls = 0.f;
#pragma unroll
            for (int kb = 0; kb < 2; ++kb)
#pragma unroll
                for (int r = 0; r < 4; ++r) { const float p = fexp2(s[kb][qb][r] - mcur); s[kb][qb][r] = p; ls += p; }
            lrow[qb] += ls;
            u32x4 w; w.x = cvt_pk_bf16(s[0][qb][0], s[0][qb][1]); w.y = cvt_pk_bf16(s[0][qb][2], s[0][qb][3]); w.z = cvt_pk_bf16(s[1][qb][0], s[1][qb][1]); w.w = cvt_pk_bf16(s[1][qb][2], s[1][qb][3]);
            const bf16x8 pb = __builtin_bit_cast(bf16x8, w);
#pragma unroll
            for (int db = 0; db < 4; ++db) o[db][qb] = __builtin_amdgcn_mfma_f32_16x16x32_bf16(vf[db], pb, o[db][qb], 0, 0, 0);
        }
#pragma unroll
        for (int kb = 0; kb < 2; ++kb)
#pragma unroll
            for (int ds = 0; ds < 2; ++ds) kf[kb][ds] = kn[kb][ds];
    }
#pragma unroll
    for (int qb = 0; qb < 4; ++qb) {
        if (qb < nqb) {
            float lt = xsum32(xsum16(lrow[qb]));
            const float inv = 1.f / lt;
#pragma unroll
            for (int db = 0; db < 4; ++db) {
                const f32x4 v = o[db][qb] * inv; u32x2 w; w.x = cvt_pk_bf16(v[0], v[1]); w.y = cvt_pk_bf16(v[2], v[3]);
                *(u32x2*)(out + (size_t)(16 * qb + fr) * 1024 + 16 * db + 4 * fq) = w;
            }
        }
    }
}

__device__ __forceinline__ void sconv_phase(const Ctx& C, int l);
__device__ __forceinline__ void attn_phase(const Ctx& C, int l, LAS unsigned char* lds) {
    const CParams Pp = get_params();
    LAS float* bt = (LAS float*)lds;
    for (int i = C.tid; i < 8 * 192; i += 512) bt[i] = Pp->in[I_RELB][l * 1536 + i] * LOG2E;
    __syncthreads();
    const bf16_t* Qh = (const bf16_t*)(Pp->ws + W_QH); const bf16_t* Kh = (const bf16_t*)(Pp->ws + W_KH); const bf16_t* VF = (const bf16_t*)(Pp->ws + W_VF);
    bf16_t* mix = (bf16_t*)(Pp->ws + W_MIX);
    if (C.wave < 4) sconv_phase(C, l);
    for (int u = C.gw; u < 8192; u += C.NGW) {
        const int bh = u >> 5, c = ((u & 31) + 8 * (u >> 11)) & 31, b = bh >> 3, h = bh & 7;
        const int nkc = (c < 8 ? c : 8) + 1, m0 = b * 2048 + c * 64, k0 = m0 - (nkc - 1) * 64;
        attn_unit(Qh + ((size_t)h * MT + m0) * 64, Kh + ((size_t)h * MT + k0) * 64, VF + ((size_t)h * NCHK + (k0 >> 6)) * 4096,
                  2 * nkc, m0 - k0, bt + h * 192, mix + (size_t)m0 * 1024 + h * 64, 4, C.lane);
    }
    {
        const bool bal = (C.NGW == 2048);
        for (int us = bal ? (((C.gw & 15) == 0) ? (C.gw >> 4) : 128) : C.gw; us < 128; us += bal ? 128 : C.NGW) {
            const int b = us >> 3, h = us & 7;
            attn_unit(Qh + ((size_t)h * MT + MP + b * 32) * 64, (const bf16_t*)(Pp->ws + W_KS) + (size_t)(l * 128 + b * 8 + h) * 544 * 64,
                      (const bf16_t*)(Pp->ws + W_VFS) + (size_t)(l * 128 + b * 8 + h) * 18 * 2048, 17, 512, bt + h * 192,
                      mix + (size_t)(MP + b * 32) * 1024 + h * 64, 2, C.lane);
        }
    }
    if (C.wave >= 4) sconv_phase(C, l);
}

__device__ __forceinline__ void sconv_phase(const Ctx& C, int l) {
    const CParams Pp = get_params();
    const bf16_t* G = (const bf16_t*)(Pp->ws + W_G); bf16_t* mix = (bf16_t*)(Pp->ws + W_MIX);
    const int c = (C.gtid & 31) * 8;
    f32x4 w0[2], w1[2], w2[2], bs[2];
#pragma unroll
    for (int k = 0; k < 2; ++k) {
        w0[k] = *(const f32x4*)(Pp->in[I_SCW] + (size_t)(l * 3 + 0) * 256 + c + 4 * k); w1[k] = *(const f32x4*)(Pp->in[I_SCW] + (size_t)(l * 3 + 1) * 256 + c + 4 * k);
        w2[k] = *(const f32x4*)(Pp->in[I_SCW] + (size_t)(l * 3 + 2) * 256 + c + 4 * k); bs[k] = *(const f32x4*)(Pp->in[I_SCB] + (size_t)l * 256 + c + 4 * k);
    }
    for (int item = C.gtid; item < MT * 32; item += C.NT) {
        const int row = item >> 5;
        const bool smp = row >= MP; const int s = smp ? ((row - MP) & 31) : (row & 2047), b = smp ? ((row - MP) >> 5) : (row >> 11);
        const bf16_t* gr = G + (size_t)row * 768 + c;
        f32x4 gb0, gb1, a0, a1, x0, x1, i0[2], i1[2], i2[2];
        unpack8(*(const u32x4*)gr, gb0, gb1); unpack8(*(const u32x4*)(gr + 256), a0, a1); unpack8(*(const u32x4*)(gr + 512), x0, x1);
        i0[0] = a0 * x0; i0[1] = a1 * x1;
        if (s >= 1) { unpack8(*(const u32x4*)(gr - 768 + 256), a0, a1); unpack8(*(const u32x4*)(gr - 768 + 512), x0, x1); i1[0] = a0 * x0; i1[1] = a1 * x1; }
        else if (smp) { const float* cp = Pp->in[I_CSC] + ((size_t)(l * 16 + b) * 2 + 1) * 256 + c; i1[0] = *(const f32x4*)cp; i1[1] = *(const f32x4*)(cp + 4); }
        else { i1[0] = (f32x4){0.f, 0.f, 0.f, 0.f}; i1[1] = i1[0]; }
        if (s >= 2) { unpack8(*(const u32x4*)(gr - 2 * 768 + 256), a0, a1); unpack8(*(const u32x4*)(gr - 2 * 768 + 512), x0, x1); i2[0] = a0 * x0; i2[1] = a1 * x1; }
        else if (smp) { const float* cp = Pp->in[I_CSC] + ((size_t)(l * 16 + b) * 2 + s) * 256 + c; i2[0] = *(const f32x4*)cp; i2[1] = *(const f32x4*)(cp + 4); }
        else { i2[0] = (f32x4){0.f, 0.f, 0.f, 0.f}; i2[1] = i2[0]; }
        const f32x4 r0 = gb0 * (w0[0] * i2[0] + w1[0] * i1[0] + w2[0] * i0[0] + bs[0]);
        const f32x4 r1 = gb1 * (w0[1] * i2[1] + w1[1] * i1[1] + w2[1] * i0[1] + bs[1]);
        *(u32x4*)(mix + (size_t)row * 1024 + 768 + c) = pack8(r0, r1);
        if (!smp && s >= 2046) { float* p = Pp->out + O_SCP + ((size_t)(l * 32 + b) * 2 + (s - 2046)) * 256 + c; *(f32x4*)p = i0[0]; *(f32x4*)(p + 4) = i0[1]; }
        if (smp && s >= 30) { float* p = Pp->out + O_SCS + ((size_t)(l * 16 + b) * 2 + (s - 30)) * 256 + c; *(f32x4*)p = i0[0]; *(f32x4*)(p + 4) = i0[1]; }
    }
}

__device__ __forceinline__ void scan_phase(const Ctx& C, int l, LAS unsigned char* lds) {
    const CParams Pp = get_params();
    bf16_t* U2 = (bf16_t*)(Pp->ws + W_U2); const float* HL = (const float*)(Pp->ws + W_HLOC);
    {
        const int gw2 = C.wave * C.G + C.bid;
        for (int w = gw2; w < 512; w += C.NGW) {
            const int idx = w * 64 + C.lane, p = idx & 63, g = (idx >> 6) & 15, b = idx >> 10;
            const float lr = Pp->in[I_LAMRE][(l * 16 + g) * 64 + p], li = Pp->in[I_LAMIM][(l * 16 + g) * 64 + p], dt = __expf(Pp->in[I_LOGDT][l * 16 + g]);
            float ar, ai; cpow_exp(lr, li, dt, 64.f, ar, ai);
            float hr = 0.f, hi = 0.f;
#pragma unroll 8
            for (int c = 0; c < 32; ++c) {
                const size_t rowi = (size_t)g * 1024 + b * 32 + c;
                U2[rowi * 1152 + 1024 + p] = f2bf(hr); U2[rowi * 1152 + 1088 + p] = f2bf(hi);
                float xr = 0.f, xi = 0.f;
#pragma unroll
                for (int ks = 0; ks < 4; ++ks) { xr += HL[((size_t)ks * 16384 + rowi) * 128 + p]; xi += HL[((size_t)ks * 16384 + rowi) * 128 + 64 + p]; }
                const float nr = ar * hr - ai * hi + xr, ni = ar * hi + ai * hr + xi; hr = nr; hi = ni;
            }
            Pp->out[O_SRP + ((size_t)(l * 32 + b) * 16 + g) * 64 + p] = hr; Pp->out[O_SIP + ((size_t)(l * 32 + b) * 16 + g) * 64 + p] = hi;
        }
    }
    LAS float* us = (LAS float*)lds; LAS float* hsr = us + 512; LAS float* hsi = hsr + 32 * 65;
    const bf16_t* US = (const bf16_t*)(Pp->ws + W_US); bf16_t* Z = (bf16_t*)(Pp->ws + W_Z);
    for (int unit = C.bid; unit < 256; unit += C.G) {
        const int b = unit >> 4, g = unit & 15;
        { const int t = C.tid >> 4, c = C.tid & 15; us[C.tid] = bf1(US[(size_t)(b * 32 + t) * 256 + g * 16 + c]); }
        __syncthreads();
        if (C.tid < 64) {
            const int p = C.tid;
            const float lr = Pp->in[I_LAMRE][(l * 16 + g) * 64 + p], li = Pp->in[I_LAMIM][(l * 16 + g) * 64 + p], dt = __expf(Pp->in[I_LOGDT][l * 16 + g]);
            float ar, ai, cr, ci; cpow_exp(lr, li, dt, 1.f, ar, ai); ssm_cf(lr, li, dt, cr, ci);
            const float* br = Pp->in[I_BRE] + ((size_t)(l * 16 + g) * 64 + p) * 16; const float* bi = Pp->in[I_BIM] + ((size_t)(l * 16 + g) * 64 + p) * 16;
            f32x4 Br[4], Bi[4];
#pragma unroll
            for (int q = 0; q < 4; ++q) { const f32x4 b_r = *(const f32x4*)(br + 4 * q), b_i = *(const f32x4*)(bi + 4 * q); Br[q] = b_r * cr - b_i * ci; Bi[q] = b_i * cr + b_r * ci; }
            const size_t si = ((size_t)(l * 16 + b) * 16 + g) * 64 + p;
            float hr = Pp->in[I_SRE][si], hi = Pp->in[I_SIM][si];
            for (int t = 0; t < 32; ++t) {
                float bur = 0.f, bui = 0.f;
#pragma unroll
                for (int q = 0; q < 4; ++q)
#pragma unroll
                    for (int e = 0; e < 4; ++e) { const float uu = us[t * 16 + 4 * q + e]; bur += Br[q][e] * uu; bui += Bi[q][e] * uu; }
                const float nr = ar * hr - ai * hi + bur, ni = ar * hi + ai * hr + bui; hr = nr; hi = ni;
                hsr[t * 65 + p] = hr; hsi[t * 65 + p] = hi;
            }
            Pp->out[O_SRS + si] = hr; Pp->out[O_SIS + si] = hi;
        }
        __syncthreads();
        {
            const int t = C.tid >> 4, c = C.tid & 15;
            const float* cre = Pp->in[I_CRE] + ((size_t)(l * 16 + g) * 16 + c) * 64; const float* cim = Pp->in[I_CIM] + ((size_t)(l * 16 + g) * 16 + c) * 64;
            float y = 0.f;
            for (int p = 0; p < 64; ++p) y += cre[p] * hsr[t * 65 + p] - cim[p] * hsi[t * 65 + p];
            y += Pp->in[I_SD][l * 256 + g * 16 + c] * us[C.tid];
            Z[(size_t)(MP + b * 32 + t) * 256 + g * 16 + c] = f2bf(gelu_tanh(y));
        }
        __syncthreads();
    }
}


#define XB_TMO      128
#define XB_XCNT(j)  (256  + 64 * (j))
#define XB_XSUB(j)  (1280 + 64 * (j))
#define XB_XGEN(j)  (2304 + 64 * (j))
#define XB_TOP      3328
#define XB_TOPGEN   3392
#define XCD_BAR_WORDS 3456
#define XB_SPIN_CAP (1u << 18)
__device__ __forceinline__ unsigned xb_ld(unsigned* p)              { return __hip_atomic_load(p, __ATOMIC_RELAXED, __HIP_MEMORY_SCOPE_AGENT); }
__device__ __forceinline__ unsigned xb_add(unsigned* p, unsigned v) { return __hip_atomic_fetch_add(p, v, __ATOMIC_RELAXED, __HIP_MEMORY_SCOPE_AGENT); }
__device__ __forceinline__ unsigned xb_xcc_id() { return (unsigned)__builtin_amdgcn_s_getreg((3 << 11) | 20) & 0xFu; }
#define XB_SPIN(cond, bar) do { unsigned _sp = 0; while (cond) { __builtin_amdgcn_s_sleep(1); \
    if ((++_sp & 255u) == 0u) { if (xb_ld(&(bar)[XB_TMO])) break; if (_sp > XB_SPIN_CAP) { atomicAdd(&(bar)[XB_TMO], 1u); break; } } } } while (0)
struct XcdBarrier { unsigned* bar; unsigned x; volatile LAS unsigned* st; };
__device__ __forceinline__ void xcd_barrier_complete(unsigned* bar, unsigned x, unsigned& nloc, unsigned& nx) {
    const unsigned G = gridDim.x * gridDim.y * gridDim.z;
    unsigned sum, cnt, mine, sp = 0u;
    for (;;) {
        sum = 0u; cnt = 0u; mine = 0u;
#pragma unroll
        for (unsigned j = 0; j < 16; ++j) { const unsigned c = xb_ld(&bar[XB_XCNT(j)]); sum += c; cnt += (c > 0u) ? 1u : 0u; mine = (j == x) ? c : mine; }
        if (sum == G) break;
        __builtin_amdgcn_s_sleep(1);
        if ((++sp & 255u) == 0u) { if (xb_ld(&bar[XB_TMO])) break; if (sp > XB_SPIN_CAP) { atomicAdd(&bar[XB_TMO], 1u); break; } }
    }
    nloc = mine > 0u ? mine : 1u; nx = cnt > 0u ? cnt : 1u;
}
__device__ __forceinline__ void xcd_barrier(const XcdBarrier& b) {
    asm volatile("s_waitcnt vmcnt(0)" ::: "memory");
    __syncthreads();
    if (threadIdx.x == 0) {
        unsigned* bar = b.bar;
        __builtin_amdgcn_s_waitcnt(0);
        unsigned nloc = b.st[0], nx = b.st[1];
        if (nloc == 0u) { xcd_barrier_complete(bar, b.x, nloc, nx); b.st[0] = nloc; b.st[1] = nx; }
        const unsigned old = xb_add(&bar[XB_XSUB(b.x)], 1u);
        const unsigned gen = old / nloc;
        if (old + 1u == (gen + 1u) * nloc) {
            __builtin_amdgcn_fence(__ATOMIC_RELEASE, "agent");
            asm volatile("s_waitcnt vmcnt(0)" ::: "memory");
            const unsigned og = xb_add(&bar[XB_TOP], 1u);
            const unsigned tg = og / nx;
            if (og + 1u == (tg + 1u) * nx) xb_add(&bar[XB_TOPGEN], 1u);
            else XB_SPIN(xb_ld(&bar[XB_TOPGEN]) == tg, bar);
            __builtin_amdgcn_fence(__ATOMIC_ACQUIRE, "agent");
            xb_add(&bar[XB_XGEN(b.x)], 1u);
            asm volatile("s_waitcnt vmcnt(0)" ::: "memory");
        } else {
            XB_SPIN(xb_ld(&bar[XB_XGEN(b.x)]) == gen, bar);
            __builtin_amdgcn_fence(__ATOMIC_ACQUIRE, "agent");
            asm volatile("s_waitcnt vmcnt(0)" ::: "memory");
        }
    }
    __syncthreads();
}

enum { ST_PROJ = 0, ST_ATTN, ST_HLOC, ST_SCAN, ST_YSSM, ST_GLU, ST_OUT, ST_LN1, ST_FFIN, ST_FFOUT, ST_PER_LAYER };
constexpr int N_STEPS = 2 + NL * ST_PER_LAYER + 1;

__global__ void __launch_bounds__(512, 2) mega(Params P) {
    extern __shared__ __attribute__((aligned(16))) unsigned char lds_raw[];
    LAS unsigned char* lds = (LAS unsigned char*)lds_raw;
    const int step_lo = get_params()->lo, step_hi = get_params()->hi;
    volatile LAS unsigned* xst = (volatile LAS unsigned*)(lds + LDS_BYTES - 64);
    if (threadIdx.x == 0) { xst[0] = 0u; xst[1] = 0u; }
    __syncthreads();
    XcdBarrier xbar; xbar.bar = (unsigned*)(get_params()->ws + 4096); xbar.x = xb_xcc_id(); xbar.st = xst;
    if (step_hi - step_lo > 1 && threadIdx.x == 0) (void)xb_add(&xbar.bar[XB_XCNT(xbar.x)], 1u);
    for (int step = step_lo; step < step_hi; ++step) {
        bool sync_after = true;
        const CParams Pp = get_params();
        int tid_ = threadIdx.x, bid_ = blockIdx.x, G_ = gridDim.x; asm volatile("" : "+v"(tid_)); asm volatile("" : "+s"(bid_), "+s"(G_));
        Ctx C; C.tid = tid_; C.lane = tid_ & 63; C.wave = __builtin_amdgcn_readfirstlane(tid_ >> 6); C.G = G_; C.bid = bid_;
        C.gtid = bid_ * 512 + tid_; C.NT = G_ * 512; C.gw = bid_ * 8 + C.wave; C.NGW = G_ * 8;
        if (step == 0) { prologue_phase(C, lds); __syncthreads(); ssm_T_phase(C, 0, lds); }
        else if (step == 1) {
            ssm_fill_phase(C, 0);
            for (int item = C.gtid; item < NL * 2560; item += C.NT) {
                const int l = item / 2560, n = item % 2560; const float* src = (const float*)(Pp->ws + W_CSP) + ((size_t)l * 16 * 2560 + n) * 2;
                float cs = 0.f, bs = 0.f;
#pragma unroll
                for (int kc = 0; kc < 16; ++kc) { cs += src[(size_t)kc * 2560 * 2]; bs += src[(size_t)kc * 2560 * 2 + 1]; }
                float* dst = (float*)(Pp->ws + W_CS) + l * CS_L + n; dst[0] = cs; dst[2560] = bs;
            }
        }
        else if (step == N_STEPS - 1) { ln_phase(C, Pp->ws, Pp->in[I_LN2G] + (NL - 1) * 1024, Pp->in[I_LN2B] + (NL - 1) * 1024, Pp->out); }
        else {
            const int l = (step - 2) / ST_PER_LAYER, st = (step - 2) % ST_PER_LAYER;
            bool is_gemm = false; pg8::Gemm g; Epi E; E.l = l; E.mode = EM_PROJ; E.sub = 0;
            g.batch = 1; g.kshift = 0; g.ablk = 64; g.nM1 = 1 << 30; g.off2 = 0;
            switch (st) {
            case ST_PROJ: is_gemm = true; E.mode = EM_PROJ; g.A = (const bf16_t*)(Pp->ws + W_XV); g.Bt = (const bf16_t*)(Pp->ws + W_WIN) + (size_t)l * NPROJ * DM; g.M = MT; g.N = NPROJ; g.K = DM; g.lda = DM; g.ldb = DM; break;
            case ST_ATTN: attn_phase(C, l, lds); if (l + 1 < NL) { __syncthreads(); ssm_T_phase(C, l + 1, lds); } sync_after = false; break;
            case ST_HLOC: is_gemm = true; E.mode = EM_HLOC; g.A = (const bf16_t*)(Pp->ws + W_U2); g.Bt = (const bf16_t*)(Pp->ws + W_HM); g.M = 1024; g.N = 256; g.K = 256; g.lda = 1152; g.ldb = 1024; g.batch = 64; g.kshift = 2; break;
            case ST_SCAN: scan_phase(C, l, lds); break;
            case ST_YSSM: is_gemm = true; E.mode = EM_YSSM; g.A = (const bf16_t*)(Pp->ws + W_U2); g.Bt = (const bf16_t*)(Pp->ws + W_YK); g.M = 1024; g.N = 1024; g.K = 1152; g.lda = 1152; g.ldb = 1152; g.batch = 16; break;
            case ST_GLU: is_gemm = true; E.mode = EM_GLU; g.A = (const bf16_t*)(Pp->ws + W_Z); g.Bt = (const bf16_t*)(Pp->ws + W_WGLU) + (size_t)l * 65536; g.M = MT; g.N = 256; g.K = 256; g.lda = 256; g.ldb = 256; break;
            case ST_OUT: if (l + 1 < NL && C.bid >= 8 && C.G > 8) { Ctx C2 = C; C2.gtid = (C.bid - 8) * 512 + C.tid; C2.NT = (C.G - 8) * 512; ssm_fill_phase(C2, l + 1); }
                         else if (l + 1 < NL && C.G <= 8) ssm_fill_phase(C, l + 1);
                         is_gemm = true; E.mode = EM_RES; g.A = (const bf16_t*)(Pp->ws + W_MIX); g.Bt = (const bf16_t*)(Pp->ws + W_WOUT) + (size_t)l * DM * DM; g.M = MT; g.N = DM; g.K = DM; g.lda = DM; g.ldb = DM; break;
            case ST_LN1: ln_phase(C, Pp->ws, Pp->in[I_LN1G] + l * 1024, Pp->in[I_LN1B] + l * 1024, nullptr); break;
            case ST_FFIN: is_gemm = true; E.mode = EM_FFIN; g.A = (const bf16_t*)(Pp->ws + W_XV) - 2 * DM; g.Bt = (const bf16_t*)(Pp->ws + W_WFFI) + (size_t)l * DFF2 * DM; g.M = (NTP + NTS) * 256; g.N = DFF2; g.K = DM; g.lda = DM; g.ldb = DM; g.ablk = 62; g.nM1 = NTP; g.off2 = (unsigned)MP * DM * 2u; break;
            case ST_FFOUT: is_gemm = true; E.mode = EM_RES; E.sub = 1; g.A = (const bf16_t*)Pp->out; g.Bt = (const bf16_t*)(Pp->ws + W_WFFO) + (size_t)l * DM * DFF; g.M = MT; g.N = DM; g.K = DFF; g.lda = DFF; g.ldb = DFF; break;
            default: break;
            }
            if (is_gemm) { __syncthreads(); pg8::Order S; S.init(g.M, g.N, g.batch, C.G, (int)C.bid); S.rev = (st == ST_FFOUT || st == ST_OUT) ? 1 : 0; pg8::gemm_phase<Epi>(lds, g, S, E, C.tid); }
            if (st == ST_FFOUT && l + 1 < NL && C.G > 8 && C.bid >= 8) {
                Ctx C2 = C; C2.bid = C.bid - 8; C2.G = C.G - 8; C2.gtid = C2.bid * 512 + C.tid; C2.NT = C2.G * 512; C2.gw = C2.bid * 8 + C.wave; C2.NGW = C2.G * 8;
                convert_layer(C2, lds, l + 1);
            }
        }
        if (step + 1 < step_hi) {
            if (!sync_after) __syncthreads(); else if (step_hi == 0x7fffffff) cg::this_grid().sync(); else xcd_barrier(xbar);
        }
    }
}

extern "C" void kernel_launch(void* const* d_in, const int* in_sizes, int n_in, void* d_out, int out_size, void* d_ws, size_t ws_size, hipStream_t stream) {
    static int grid = 0;
    if (grid == 0) {
        if (n_in != 32 || (size_t)out_size != O_END || ws_size < W_END) { fprintf(stderr, "kernel_launch: unexpected sizes n_in=%d out=%d ws=%zu (need %zu)\n", n_in, out_size, ws_size, (size_t)W_END); grid = -1; return; }
        int dev = 0, cus = 0, per_cu = 0;
        hipGetDevice(&dev); hipDeviceGetAttribute(&cus, hipDeviceAttributeMultiprocessorCount, dev);
        hipFuncSetAttribute((const void*)mega, hipFuncAttributeMaxDynamicSharedMemorySize, LDS_BYTES);
        hipOccupancyMaxActiveBlocksPerMultiprocessor(&per_cu, (const void*)mega, 512, LDS_BYTES);
        if (per_cu < 1) { fprintf(stderr, "kernel_launch: occupancy query says %d blocks/CU\n", per_cu); per_cu = 1; }
        (void)hipGetLastError();
        grid = cus;
    }
    if (grid < 0) return;
    Params p{};
    for (int i = 0; i < 32; ++i) p.in[i] = (const float*)d_in[i];
    p.out = (float*)d_out; p.ws = (unsigned char*)d_ws;
#if SINGLE_LAUNCH
    hipMemsetAsync(d_ws, 0, 65536, stream);
    p.lo = 0; p.hi = N_STEPS;
    void* args[] = {&p};
    hipError_t e = hipLaunchCooperativeKernel((const void*)mega, dim3(grid), dim3(512), args, LDS_BYTES, stream);
    if (e != hipSuccess) fprintf(stderr, "cooperative launch failed: %s (grid %d)\n", hipGetErrorString(e), grid);
#else
#ifndef DBG_NSTEP
#define DBG_NSTEP N_STEPS
#endif
    for (int s = 0; s < DBG_NSTEP; ++s) {
        p.lo = s; p.hi = s + 1;
        hipLaunchKernelGGL(mega, dim3(grid), dim3(512), LDS_BYTES, stream, p);
    }
#ifdef DBG_DUMP
    hipMemcpyAsync(d_out, (unsigned char*)d_ws + DBG_DUMP, (size_t)500 * 1024 * 1024, hipMemcpyDeviceToDevice, stream);
#endif
#endif
}
```

```cpp
#include <hip/hip_runtime.h>
#include <hip/hip_cooperative_groups.h>
#include <cstdio>
#include <cstdint>
namespace cg = cooperative_groups;

#ifndef SINGLE_LAUNCH
#define SINGLE_LAUNCH 1
#endif

#define LAS __attribute__((address_space(3)))
typedef unsigned short bf16_t;
typedef short bf16x8 __attribute__((ext_vector_type(8)));
typedef float f32x4 __attribute__((ext_vector_type(4)));
typedef unsigned u32x4 __attribute__((ext_vector_type(4)));
typedef unsigned u32x2 __attribute__((ext_vector_type(2)));

constexpr int MP = 65536, MS = 512, MT = MP + MS;
constexpr int DM = 1024, NPROJ = 2560, DFF2 = 4096, DFF = 2048, NL = 4;
constexpr float ALPHA = 1.681792830507429f;
constexpr float LN_EPS = 1e-5f;
constexpr float LOG2E = 1.4426950408889634f;
constexpr int NCHK = 1032;

constexpr size_t O_Y = 0;
constexpr size_t O_KP = (size_t)MT * DM;
constexpr size_t O_VP = O_KP + (size_t)NL * 32 * 512 * 512;
constexpr size_t O_KS = O_VP + (size_t)NL * 32 * 512 * 512;
constexpr size_t O_VS = O_KS + (size_t)NL * 16 * 32 * 512;
constexpr size_t O_SRP = O_VS + (size_t)NL * 16 * 32 * 512;
constexpr size_t O_SIP = O_SRP + (size_t)NL * 32 * 16 * 64;
constexpr size_t O_SRS = O_SIP + (size_t)NL * 32 * 16 * 64;
constexpr size_t O_SIS = O_SRS + (size_t)NL * 16 * 16 * 64;
constexpr size_t O_SCP = O_SIS + (size_t)NL * 16 * 16 * 64;
constexpr size_t O_SCS = O_SCP + (size_t)NL * 32 * 2 * 256;
constexpr size_t O_FFP = O_SCS + (size_t)NL * 16 * 2 * 256;
constexpr size_t O_FFS = O_FFP + (size_t)NL * 32 * 2 * 4096;
constexpr size_t O_END = O_FFS + (size_t)NL * 16 * 2 * 4096;
static_assert(O_END == 138903552, "out size");

constexpr size_t W_WIN = 1u << 20;
constexpr size_t W_WOUT = W_WIN + (size_t)NL * NPROJ * DM * 2;
constexpr size_t W_WFFI = W_WOUT + (size_t)NL * DM * DM * 2;
constexpr size_t W_WFFO = W_WFFI + (size_t)NL * DFF2 * DM * 2;
constexpr size_t W_WGLU = W_WFFO + (size_t)NL * DM * DFF * 2;
constexpr size_t W_SSMT = W_WGLU + (size_t)NL * 256 * 256 * 2;
constexpr size_t W_YK = W_SSMT + (size_t)16 * 64 * 256 * 4;
constexpr size_t W_HM = W_YK + (size_t)16 * 1024 * 1152 * 2;
constexpr size_t W_HLOC = W_HM + (size_t)16 * 256 * 1024 * 2;
constexpr size_t W_XV = W_HLOC + (size_t)4 * 16 * 1024 * 128 * 4;
constexpr size_t W_KS = W_XV + (size_t)MT * DM * 2;
constexpr size_t W_VFS = W_KS + (size_t)NL * 128 * 544 * 64 * 2;
constexpr size_t W_US = W_VFS + (size_t)NL * 128 * 18 * 2048 * 2;
constexpr size_t W_CW = W_US + (size_t)MS * 256 * 2;
constexpr size_t W_STA = W_CW + (size_t)NL * 512 * 32 * 4;
constexpr size_t W_STB = W_STA + (size_t)MT * 32;
constexpr size_t W_CS = W_STB + (size_t)MT * 32;
constexpr int CS_L = 13312;
constexpr size_t W_ONE = W_CS + (size_t)NL * CS_L * 4;
constexpr size_t W_CSP = W_ONE + 8192;
constexpr size_t W_RA = W_CSP + (size_t)NL * 16 * 2560 * 8;
constexpr size_t W_QH = W_RA;
constexpr size_t W_KH = W_QH + (size_t)8 * MT * 64 * 2;
constexpr size_t W_VF = W_KH + (size_t)8 * MT * 64 * 2;
constexpr size_t W_U2 = W_VF + (size_t)8 * NCHK * 4096 * 2;
constexpr size_t W_G = W_U2 + (size_t)16 * 1024 * 1152 * 2;
constexpr size_t W_MIX = W_G + (size_t)MT * 768 * 2;
constexpr size_t W_Z = W_MIX + (size_t)MT * DM * 2;
constexpr size_t W_RA_END1 = W_Z + (size_t)MT * 256 * 2;
constexpr size_t W_END = W_RA_END1;
static_assert(W_END < (size_t)1000 * 1024 * 1024, "ws budget");

constexpr int LDS_RED = 131072;
constexpr int LDS_RS = LDS_RED + 8192;
constexpr int LDS_ST = LDS_RS + 2048;
constexpr int LDS_BYTES = 131072 + 8192 + 2048 + 16384 + 1024;

struct Params {
    const float* in[32];
    float* out;
    unsigned char* ws;
    int lo, hi;
};
typedef const Params __attribute__((address_space(4)))* CParams;
__device__ __forceinline__ CParams get_params() { CParams p = (CParams)__builtin_amdgcn_kernarg_segment_ptr(); asm volatile("" : "+s"(p)); return p; }
enum { I_XP = 0, I_XS, I_CK, I_CV, I_SRE, I_SIM, I_CSC, I_CFF, I_LNG, I_LNB, I_WIN, I_RELB, I_LAMRE, I_LAMIM, I_LOGDT,
       I_BRE, I_BIM, I_CRE, I_CIM, I_SD, I_WGLU, I_SCW, I_SCB, I_WOUT, I_LN1G, I_LN1B, I_WFFI, I_FCW, I_FCB, I_WFFO, I_LN2G, I_LN2B };

typedef float f32x2_t __attribute__((ext_vector_type(2))); typedef __bf16 bf16x2_t __attribute__((ext_vector_type(2)));
__device__ __forceinline__ unsigned cvt_pk_bf16(float lo, float hi) { f32x2_t v = {lo, hi}; bf16x2_t b = __builtin_convertvector(v, bf16x2_t); return __builtin_bit_cast(unsigned, b); }
__device__ __forceinline__ float bf_lo(unsigned w) { return __uint_as_float(w << 16); }
__device__ __forceinline__ float bf_hi(unsigned w) { return __uint_as_float(w & 0xffff0000u); }
__device__ __forceinline__ float bf1(bf16_t b) { return __uint_as_float(((unsigned)b) << 16); }
__device__ __forceinline__ bf16_t f2bf(float f) { return (bf16_t)(cvt_pk_bf16(f, 0.f) & 0xffffu); }
__device__ __forceinline__ u32x4 pack8(const f32x4 a, const f32x4 b) { u32x4 w; w.x = cvt_pk_bf16(a[0], a[1]); w.y = cvt_pk_bf16(a[2], a[3]); w.z = cvt_pk_bf16(b[0], b[1]); w.w = cvt_pk_bf16(b[2], b[3]); return w; }
__device__ __forceinline__ void unpack8(const u32x4 w, f32x4& a, f32x4& b) { a = (f32x4){bf_lo(w.x), bf_hi(w.x), bf_lo(w.y), bf_hi(w.y)}; b = (f32x4){bf_lo(w.z), bf_hi(w.z), bf_lo(w.w), bf_hi(w.w)}; }
__device__ __forceinline__ float fexp2(float x) { return __builtin_amdgcn_exp2f(x); }
__device__ __forceinline__ float frcp(float x) { return __builtin_amdgcn_rcpf(x); }
__device__ __forceinline__ float sigmoidf_(float a) { return frcp(1.f + fexp2(-LOG2E * a)); }
__device__ __forceinline__ float gelu_tanh(float y) { const float t = y + 0.044715f * y * y * y; return y * frcp(1.f + fexp2(-2.f * 0.7978845608028654f * LOG2E * t)); }
template <int CTRL> __device__ __forceinline__ float dpp_mov(float v) { return __int_as_float(__builtin_amdgcn_update_dpp(0, __float_as_int(v), CTRL, 0xF, 0xF, true)); }
__device__ __forceinline__ float xsum16(float v) { auto r = __builtin_amdgcn_permlane16_swap(__float_as_uint(v), __float_as_uint(v), false, false); return __uint_as_float(r[0]) + __uint_as_float(r[1]); }
__device__ __forceinline__ float xsum32(float v) { auto r = __builtin_amdgcn_permlane32_swap(__float_as_uint(v), __float_as_uint(v), false, false); return __uint_as_float(r[0]) + __uint_as_float(r[1]); }
__device__ __forceinline__ float xmax16(float v) { auto r = __builtin_amdgcn_permlane16_swap(__float_as_uint(v), __float_as_uint(v), false, false); return fmaxf(__uint_as_float(r[0]), __uint_as_float(r[1])); }
__device__ __forceinline__ float xmax32(float v) { auto r = __builtin_amdgcn_permlane32_swap(__float_as_uint(v), __float_as_uint(v), false, false); return fmaxf(__uint_as_float(r[0]), __uint_as_float(r[1])); }
__device__ __forceinline__ float wave_sum(float v) {
    v += dpp_mov<0xB1>(v); v += dpp_mov<0x4E>(v); v += dpp_mov<0x141>(v); v += dpp_mov<0x140>(v);
    return xsum32(xsum16(v));
}
__device__ __forceinline__ void cpow_exp(float lr, float li, float dt, float tau, float& er, float& ei) {
    const float mag = __expf(lr * dt * tau); const float th = (li * dt) * tau;
    const float k = rintf(th * 0.15915494309189535f);
    float r = fmaf(-k, 6.28318548202514648f, th); r = fmaf(-k, -1.7484555e-7f, r);
    const float rev = r * 0.15915494309189535f;
    const float s = __builtin_amdgcn_sinf(rev), c = __builtin_amdgcn_cosf(rev);
    er = mag * c; ei = mag * s;
}
__device__ __forceinline__ void ssm_cf(float lr, float li, float dt, float& cr, float& ci) {
    float er, ei; cpow_exp(lr, li, dt, 1.f, er, ei);
    const float nr = er - 1.f, ni = ei; const float den = frcp(lr * lr + li * li) ;
    cr = (nr * lr + ni * li) * den; ci = (ni * lr - nr * li) * den;
}

namespace pg8 {
constexpr int BM = 256, BK = 64, HALF = 128, HTB = HALF * BK * 2, NXCD = 8, WGM = 8;
__device__ __forceinline__ int lds_byte(int r, int c) { const int st = (r >> 4) * 2 + (c >> 5), rr = r & 15, cc = c & 31, ob = rr * 64 + cc * 2; return st * 1024 + (ob ^ (((ob >> 9) & 1) << 5)); }
__device__ __forceinline__ void stage_rc(int b, int& R, int& C) { const int st = b / 1024, sb = b % 1024, swz = sb ^ (((sb >> 9) & 1) << 5); R = (st >> 1) * 16 + swz / 64; C = (st & 1) * 32 + (swz % 64) / 2; }
__device__ __forceinline__ int perm32(int rho) { const int n = rho >> 4, i = rho & 15; return 8 * (i >> 2) + 4 * n + (i & 3); }

struct Unit { int pm, pn, bz; };
struct Gemm { const bf16_t* A; const bf16_t* Bt; int M, N, K, lda, ldb, batch; int ablk, nM1; unsigned off2; int kshift; };

struct Order {
    int nM, nN, nwg, total, G, c, rev;
    __device__ __forceinline__ void init(int M, int N, int batch, int G_, int c_) { nM = M / BM; nN = N / BM; nwg = nM * nN; total = nwg * batch; G = G_; c = c_; rev = 0; }
    __device__ __forceinline__ bool next(int i, Unit& u) const {
        const long L = (long)i * G + c; if (L >= total) return false;
        const int bz = (int)(L / nwg); int wgid = (int)(L % nwg);
        { const int q = nwg / NXCD, r = nwg % NXCD, xcd = wgid % NXCD; int off = wgid / NXCD; if (rev) off = (q + (xcd < r ? 1 : 0)) - 1 - off; wgid = (xcd < r ? xcd * (q + 1) : r * (q + 1) + (xcd - r) * q) + off; }
        const int nig = WGM * nN, gid = wgid / nig, fm = gid * WGM, gsz = (nM - fm) < WGM ? (nM - fm) : WGM;
        u.pm = fm + ((wgid % nig) % gsz); u.pn = (wgid % nig) / gsz; u.bz = bz; return true;
    }
};

template <class Epi>
__device__ __forceinline__ void gemm_phase(LAS unsigned char* lds, const Gemm g, const Order& S, const Epi& E, const int tid) {
    const int wid = __builtin_amdgcn_readfirstlane(tid >> 6), lane = tid & 63, wr = wid >> 2, wc = wid & 3, fr = lane & 15, fq = lane >> 4;
    const int nt = g.K / BK;
    unsigned voffA[2], voffB[2];
#pragma unroll
    for (int i = 0; i < 2; ++i) { int R, C; stage_rc(tid * 16 + i * 8192, R, C); const int Rb = (R & ~31) + perm32(R & 31);
        voffA[i] = (unsigned)((g.ablk * (R >> 6) + (R & 63)) * g.lda + C) * 2u; voffB[i] = (unsigned)(Rb * g.ldb + C) * 2u; }
    const size_t kstep = (size_t)(BK * 2);
    const unsigned hstepA = 2u * g.ablk * g.lda * 2u, hstepB = (unsigned)HALF * g.ldb * 2u;
    const unsigned tstepA = 2 * hstepA, tstepB = 2 * hstepB;
    const int nMb = g.M / BM, nNb = g.N / BM;
    const unsigned ldsw = (unsigned)wid * 1024u;
    const int aoff = lds_byte(wr * 64 + fr, fq * 8), boff = lds_byte(wc * 32 + fr, fq * 8);
#define PG8_SA(b, h) (((b) * 2 + (h)) * HTB)
#define PG8_SB(b, h) ((4 + (b) * 2 + (h)) * HTB)
#define PG8_STAGE(bufoff, gbase, voff) do { _Pragma("unroll") for (int _i = 0; _i < 2; ++_i) \
        __builtin_amdgcn_global_load_lds((const unsigned*)((const char*)(gbase) + (voff)[_i]), (LAS unsigned*)(lds + (bufoff) + ldsw + _i * 8192), 16, 0, 0); } while (0)
#define PG8_LDA(dst, b, h) do { _Pragma("unroll") for (int m = 0; m < 4; ++m) _Pragma("unroll") for (int k = 0; k < 2; ++k) dst[m][k] = *(const LAS bf16x8*)(lds + PG8_SA(b, h) + aoff + m * 2048 + k * 1024); } while (0)
#define PG8_LDB(dst, b, h) do { _Pragma("unroll") for (int n = 0; n < 2; ++n) _Pragma("unroll") for (int k = 0; k < 2; ++k) dst[n][k] = *(const LAS bf16x8*)(lds + PG8_SB(b, h) + boff + n * 2048 + k * 1024); } while (0)
#define PG8_MMA(ai, bj, At, Bt) do { __builtin_amdgcn_s_setprio(1); _Pragma("unroll") for (int m = 0; m < 4; ++m) _Pragma("unroll") for (int n = 0; n < 2; ++n) _Pragma("unroll") for (int k = 0; k < 2; ++k) \
        acc[ai][bj][m][n] = __builtin_amdgcn_mfma_f32_16x16x32_bf16(Bt[n][k], At[m][k], acc[ai][bj][m][n], 0, 0, 0); __builtin_amdgcn_s_setprio(0); } while (0)
#define PG8_WAIT_V(n) asm volatile("s_waitcnt vmcnt(" #n ")" ::: "memory")
#define PG8_WAIT_L(n) asm volatile("s_waitcnt lgkmcnt(" #n ")" ::: "memory")
#define PG8_BAR __builtin_amdgcn_s_barrier()
#define PG8_SCHED __builtin_amdgcn_sched_barrier(0)
    Unit cur, nxt; int ui = 0;
    if (!S.next(0, cur)) return;
    f32x4 acc[2][2][4][2];
#pragma unroll
    for (int a = 0; a < 2; ++a)
#pragma unroll
        for (int b = 0; b < 2; ++b)
#pragma unroll
            for (int m = 0; m < 4; ++m)
#pragma unroll
                for (int n = 0; n < 2; ++n) acc[a][b][m][n] = (f32x4){0.f, 0.f, 0.f, 0.f};
    bf16x8 At[4][2], B0[2][2], B1[2][2];
#define PG8_KOFF(u_) ((unsigned)(((u_).bz & ((1 << g.kshift) - 1)) * g.K) * 2u)
#define PG8_ABASE(u_) ((const char*)g.A + PG8_KOFF(u_) + ((u_).pm < g.nM1 ? (size_t)(((u_).bz >> g.kshift) * nMb + (u_).pm) * tstepA : (size_t)g.off2 + (size_t)((u_).pm - g.nM1) * tstepA))
#define PG8_BBASE(u_) ((const char*)g.Bt + PG8_KOFF(u_) + (size_t)(((u_).bz >> g.kshift) * nNb + (u_).pn) * tstepB)
    E.prefetch(lds, cur, 0, tid);
    const char* cA = PG8_ABASE(cur);
    const char* cB = PG8_BBASE(cur);
    PG8_STAGE(PG8_SB(0, 0), cB, voffB); PG8_STAGE(PG8_SB(0, 1), cB + hstepB, voffB); PG8_STAGE(PG8_SA(0, 0), cA, voffA); PG8_STAGE(PG8_SA(0, 1), cA + hstepA, voffA);
    if (wr == 1) PG8_BAR;
    PG8_WAIT_V(2); PG8_BAR;
    PG8_STAGE(PG8_SB(1, 0), cB + kstep, voffB); PG8_STAGE(PG8_SA(1, 0), cA + kstep, voffA); PG8_STAGE(PG8_SB(1, 1), cB + hstepB + kstep, voffB);
    PG8_WAIT_V(6); PG8_BAR;
    for (;;) {
        const bool has_next = S.next(ui + 1, nxt);
        const char* nA = has_next ? PG8_ABASE(nxt) : cA;
        const char* nB = has_next ? PG8_BBASE(nxt) : cB;
        for (int t = 0; t < nt; t += 2) {
            const bool last = (t == nt - 2);
            const char* a1 = cA + (size_t)(t + 1) * kstep;
            const char* a2 = last ? nA : cA + (size_t)(t + 2) * kstep; const char* b2 = last ? nB : cB + (size_t)(t + 2) * kstep;
            const char* a3 = a2 + kstep; const char* b3 = b2 + kstep;
            PG8_LDB(B0, 0, 0); PG8_LDB(B1, 0, 1); PG8_SCHED; PG8_LDA(At, 0, 0); PG8_STAGE(PG8_SA(1, 1), a1 + hstepA, voffA);
            PG8_WAIT_V(8); PG8_WAIT_L(0); PG8_BAR; PG8_MMA(0, 0, At, B0); PG8_MMA(0, 1, At, B1); PG8_BAR; PG8_SCHED;
            PG8_LDA(At, 0, 1); PG8_STAGE(PG8_SB(0, 0), b2, voffB); PG8_STAGE(PG8_SB(0, 1), b2 + hstepB, voffB); PG8_STAGE(PG8_SA(0, 0), a2, voffA);
            PG8_WAIT_V(8); PG8_WAIT_L(0); PG8_BAR; PG8_MMA(1, 0, At, B0); PG8_MMA(1, 1, At, B1); PG8_BAR; PG8_SCHED;
            PG8_LDB(B0, 1, 0); PG8_LDB(B1, 1, 1); PG8_SCHED; PG8_LDA(At, 1, 0); PG8_STAGE(PG8_SA(0, 1), a2 + hstepA, voffA);
            PG8_WAIT_V(8); PG8_WAIT_L(0); PG8_BAR; PG8_MMA(0, 0, At, B0); PG8_MMA(0, 1, At, B1); PG8_BAR; PG8_SCHED;
            PG8_LDA(At, 1, 1); PG8_STAGE(PG8_SB(1, 0), b3, voffB); PG8_STAGE(PG8_SB(1, 1), b3 + hstepB, voffB); PG8_STAGE(PG8_SA(1, 0), a3, voffA);
            PG8_WAIT_V(8); PG8_WAIT_L(0); PG8_BAR; PG8_MMA(1, 0, At, B0); PG8_MMA(1, 1, At, B1); PG8_BAR; PG8_SCHED;
        }
        if (wr == 0) PG8_BAR;
        { int t2 = threadIdx.x; asm volatile("" : "+v"(t2));
          const int w2 = __builtin_amdgcn_readfirstlane(t2 >> 6), l2 = t2 & 63; E(acc, cur, w2 >> 2, w2 & 3, l2 & 15, l2 >> 4, ui & 1); }
        if (!has_next) break;
#pragma unroll
        for (int a = 0; a < 2; ++a)
#pragma unroll
            for (int b = 0; b < 2; ++b)
#pragma unroll
                for (int m = 0; m < 4; ++m)
#pragma unroll
                    for (int n = 0; n < 2; ++n) acc[a][b][m][n] = (f32x4){0.f, 0.f, 0.f, 0.f};
        cur = nxt; cA = nA; cB = nB; ++ui;
        E.prefetch(lds, cur, ui & 1, tid);
        if (wr == 1) PG8_BAR;
    }
    PG8_WAIT_V(0);
    PG8_BAR;
#undef PG8_ABASE
#undef PG8_KOFF
#undef PG8_BBASE
#undef PG8_SA
#undef PG8_SB
#undef PG8_STAGE
#undef PG8_LDA
#undef PG8_LDB
#undef PG8_MMA
#undef PG8_WAIT_V
#undef PG8_WAIT_L
#undef PG8_BAR
#undef PG8_SCHED
}
}

enum { EM_PROJ = 0, EM_HLOC, EM_YSSM, EM_GLU, EM_RES, EM_FFIN };
constexpr int NTP = 265, NTS = 3;
template <int CTRL> __device__ __forceinline__ float dppf(float old_, float src) { return __int_as_float(__builtin_amdgcn_update_dpp(__float_as_int(old_), __float_as_int(src), CTRL, 0xF, 0xF, false)); }
__device__ __forceinline__ float shift1(float cur, float prev) { return dppf<0x111>(dppf<0x121>(0.f, prev), cur); }
__device__ __forceinline__ float shift2(float cur, float prev) { return dppf<0x112>(dppf<0x122>(0.f, prev), cur); }
#define GST16(base, boff, val) (*(u32x4*)((unsigned char*)(base) + (unsigned)(boff)) = (val))
#define GSTF4(base, boff, val) (*(f32x4*)((unsigned char*)(base) + (unsigned)(boff)) = (val))
#define GST2(base, boff, val) (*(bf16_t*)((unsigned char*)(base) + (unsigned)(boff)) = (val))
#define GLD16(base, boff) (*(const u32x4*)((const unsigned char*)(base) + (unsigned)(boff)))
#define EPI_FENCE() asm volatile("" ::: "memory")
#define ROWSTAT(stb, row, mean_, rstd_) do { const f32x4 p0_ = *(const f32x4*)((stb) + (unsigned)(row) * 32u), p1_ = *(const f32x4*)((stb) + (unsigned)(row) * 32u + 16u); \
    mean_ = ((p0_[0] + p0_[2]) + (p1_[0] + p1_[2])) * (1.f / 1024.f); const float ex2_ = ((p0_[1] + p0_[3]) + (p1_[1] + p1_[3])) * (1.f / 1024.f); \
    rstd_ = __builtin_amdgcn_rsqf(ex2_ - mean_ * mean_ + LN_EPS); } while (0)
#define EPI_ROWSTATS_TO_LDS(stb) do { int t3_ = threadIdx.x; asm volatile("" : "+v"(t3_)); \
    if (t3_ < 256) { float mn_, rs_; ROWSTAT(stb, u.pm * 256 + t3_, mn_, rs_); LAS float* rsl_ = (LAS float*)(unsigned)LDS_RS; rsl_[2 * t3_] = mn_; rsl_[2 * t3_ + 1] = rs_; } \
    asm volatile("s_waitcnt lgkmcnt(0)" ::: "memory"); __builtin_amdgcn_s_barrier(); asm volatile("" ::: "memory"); } while (0)
#define EPI_RS(ai, m) (((const LAS float*)(unsigned)LDS_RS) + 2 * ((ai) * 128 + wr * 64 + (m) * 16 + fr_))
#define EPI_RSP(ai, m, mean_, rstd_) do { const LAS f32x4* pp_ = (const LAS f32x4*)(unsigned)(LDS_ST + par * 8192 + ((ai) * 128 + wr * 64 + (m) * 16 + fr_) * 32); const f32x4 p0_ = pp_[0], p1_ = pp_[1]; \
    mean_ = ((p0_[0] + p0_[2]) + (p1_[0] + p1_[2])) * (1.f / 1024.f); const float ex2_ = ((p0_[1] + p0_[3]) + (p1_[1] + p1_[3])) * (1.f / 1024.f); \
    rstd_ = __builtin_amdgcn_rsqf(ex2_ - mean_ * mean_ + LN_EPS); } while (0)
#define LN_CORRECT(cs_, bs_, colbase_) do { \
    _Pragma("unroll") for (int bj = 0; bj < 2; ++bj) _Pragma("unroll") for (int n = 0; n < 2; ++n) { const unsigned c4_ = (colbase_) + 128 * bj + 4 * n; \
        const f32x4 cc_ = *(const f32x4*)((cs_) + c4_), bb_ = *(const f32x4*)((bs_) + c4_); \
        _Pragma("unroll") for (int ai = 0; ai < 2; ++ai) _Pragma("unroll") for (int m = 0; m < 4; ++m) { const LAS float* rp_ = EPI_RS(ai, m); const float mn_ = rp_[0], rs_ = rp_[1]; \
            acc[ai][bj][m][n] = (acc[ai][bj][m][n] - cc_ * mn_) * rs_ + bb_; } } } while (0)
struct Epi {
    int mode, l;
    int sub;
    __device__ __forceinline__ void prefetch(LAS unsigned char* lds, const pg8::Unit& u, int par, int tid) const {
        const int wv = __builtin_amdgcn_readfirstlane(tid >> 6), ln = tid & 63;
        if (mode == EM_FFIN) {
            if (wv < 4) { const CParams Pf = get_params();
                __builtin_amdgcn_global_load_lds((const unsigned*)(Pf->ws + W_CW + (unsigned)((l * 512 + 32 * u.pn) * 128 + wv * 1024 + ln * 16)), (LAS unsigned*)(lds + LDS_RED + par * 4096 + wv * 1024), 16, 0, 0); }
        } else if (mode == EM_PROJ || (mode == EM_RES && sub == 0)) {
            const CParams Pf = get_params();
            __builtin_amdgcn_global_load_lds((const unsigned*)(Pf->ws + W_STA + (unsigned)(u.pm * 8192 + wv * 1024 + ln * 16)), (LAS unsigned*)(lds + LDS_ST + par * 8192 + wv * 1024), 16, 0, 0);
        }
    }
    __device__ __forceinline__ void operator()(f32x4 (&acc)[2][2][4][2], const pg8::Unit& u, int wr, int wc, int fr, int fq, int par) const {
#define EPI_COORDS() const CParams Pq = get_params(); float* const out = Pq->out; unsigned char* const ws = Pq->ws; (void)out; (void)ws; int fr_ = fr, fq_ = fq; asm volatile("" : "+v"(fr_), "+v"(fq_)); const unsigned rowb = (unsigned)(u.pm * 256 + wr * 64 + fr_); const unsigned colw = (unsigned)(wc * 32 + 8 * fq_); (void)rowb; (void)colw
        if (mode == EM_PROJ) {
            EPI_COORDS();
            const int pn = u.pn;
            {
                const float* cs = (const float*)(ws + W_CS) + l * CS_L;
                f32x4 cc_[2][2], bb_[2][2];
#pragma unroll
                for (int bj = 0; bj < 2; ++bj)
#pragma unroll
                    for (int n = 0; n < 2; ++n) { const unsigned c4_ = 256 * pn + colw + 128 * bj + 4 * n; cc_[bj][n] = *(const f32x4*)(cs + c4_); bb_[bj][n] = *(const f32x4*)(cs + 2560 + c4_); }
#pragma unroll
                for (int ai = 0; ai < 2; ++ai)
#pragma unroll
                    for (int m = 0; m < 4; ++m) { float mn_, rs_; EPI_RSP(ai, m, mn_, rs_);
#pragma unroll
                        for (int bj = 0; bj < 2; ++bj)
#pragma unroll
                            for (int n = 0; n < 2; ++n) acc[ai][bj][m][n] = (acc[ai][bj][m][n] - cc_[bj][n] * mn_) * rs_ + bb_[bj][n]; }
            }
            if (pn < 4) {
                const bool isk = pn >= 2; const unsigned pq = pn & 1;
                unsigned char* dst = ws + (isk ? W_KH : W_QH);
                const float sc = isk ? 1.f : 0.125f * LOG2E;
                const bool smp = u.pm >= 256; const bool tail = (u.pm & 7) >= 6;
                const unsigned d0 = 32 * (wc & 1) + 8 * fq_;
#pragma unroll
                for (int bj = 0; bj < 2; ++bj) {
                    const unsigned h = 4 * pq + 2 * bj + (wc >> 1);
                    const unsigned colk = 256 * pq + 128 * bj + colw;
#pragma unroll
                    for (int ai = 0; ai < 2; ++ai)
#pragma unroll
                        for (int m = 0; m < 4; ++m) {
                            const unsigned row = rowb + ai * 128 + m * 16;
                            const f32x4 v0 = acc[ai][bj][m][0], v1 = acc[ai][bj][m][1];
                            GST16(dst, ((h * MT + row) * 64 + d0) * 2, pack8(v0 * sc, v1 * sc));
                            if (isk) {
                                if (!smp) {
                                    if (tail) { const unsigned s = row & 2047, b = row >> 11; const unsigned o = (((l * 32 + b) * 512 + (s - 1536)) * 512 + colk) * 4;
                                        GSTF4(out + O_KP, o, v0); GSTF4(out + O_KP, o + 16, v1); }
                                } else {
                                    const unsigned ms = row - MP; const unsigned o = ((l * 512 + ms) * 512 + colk) * 4;
                                    GSTF4(out + O_KS, o, v0); GSTF4(out + O_KS, o + 16, v1);
                                    GST16(ws + W_KS, (((l * 128 + (ms >> 5) * 8 + h) * 544 + 512 + (ms & 31)) * 64 + d0) * 2, pack8(v0, v1));
                                }
                            }
                            EPI_FENCE();
                        }
                }
            } else if (pn < 6) {
                const unsigned pq = pn - 4;
                const bool smp = u.pm >= 256; const bool tail = (u.pm & 7) >= 6;
                const unsigned db = 2 * (wc & 1) + (fq_ >> 1), fqv = fr_ >> 2;
#pragma unroll
                for (int bj = 0; bj < 2; ++bj) {
                    const unsigned h = 4 * pq + 2 * bj + (wc >> 1);
                    const unsigned colk = 256 * pq + 128 * bj + colw;
#pragma unroll
                    for (int ai = 0; ai < 2; ++ai)
#pragma unroll
                        for (int m = 0; m < 4; ++m) {
                            const unsigned row = rowb + ai * 128 + m * 16;
                            const unsigned gc = 4 * u.pm + 2 * ai + wr, st = m >> 1, ii = (fr_ & 3) + 4 * (m & 1);
                            const f32x4 v0 = acc[ai][bj][m][0], v1 = acc[ai][bj][m][1];
                            const unsigned pb = ((((((h * NCHK + gc) * 2 + st) * 4 + db) * 64 + fqv * 16 + 8 * (fq_ & 1)) * 8) + ii) * 2;
#pragma unroll
                            for (int e = 0; e < 4; ++e) { GST2(ws + W_VF, pb + e * 16, f2bf(v0[e])); GST2(ws + W_VF, pb + (4 + e) * 16, f2bf(v1[e])); }
                            if (!smp) {
                                if (tail) { const unsigned s = row & 2047, b = row >> 11; const unsigned o = (((l * 32 + b) * 512 + (s - 1536)) * 512 + colk) * 4;
                                    GSTF4(out + O_VP, o, v0); GSTF4(out + O_VP, o + 16, v1); }
                            } else {
                                const unsigned ms = row - MP, t = ms & 31; const unsigned o = ((l * 512 + ms) * 512 + colk) * 4;
                                GSTF4(out + O_VS, o, v0); GSTF4(out + O_VS, o + 16, v1);
                                const unsigned i2 = (t & 3) + 4 * (t >> 4), fq2 = (t & 15) >> 2;
                                const unsigned ps = ((((((l * 128 + (ms >> 5) * 8 + h) * 18 + 16) * 4 + db) * 64 + fq2 * 16 + 8 * (fq_ & 1)) * 8) + i2) * 2;
#pragma unroll
                                for (int e = 0; e < 4; ++e) { GST2(ws + W_VFS, ps + e * 16, f2bf(v0[e])); GST2(ws + W_VFS, ps + (4 + e) * 16, f2bf(v1[e])); }
                            }
                            EPI_FENCE();
                        }
                }
            } else if (pn == 6) {
                const bool smp = u.pm >= 256;
#pragma unroll
                for (int bj = 0; bj < 2; ++bj) {
                    const unsigned col = 128 * bj + colw, g = col >> 4, ch0 = col & 15;
#pragma unroll
                    for (int ai = 0; ai < 2; ++ai)
#pragma unroll
                        for (int m = 0; m < 4; ++m) {
                            const unsigned row = rowb + ai * 128 + m * 16;
                            const u32x4 w = pack8(acc[ai][bj][m][0], acc[ai][bj][m][1]);
                            if (!smp) GST16(ws + W_U2, ((g * 1024 + (row >> 6)) * 1152 + (row & 63) * 16 + ch0) * 2, w);
                            else GST16(ws + W_US, ((row - MP) * 256 + col) * 2, w);
                            EPI_FENCE();
                        }
                }
            } else {
#pragma unroll
                for (int bj = 0; bj < 2; ++bj) {
                    const unsigned col = (pn - 7) * 256 + 128 * bj + colw;
#pragma unroll
                    for (int ai = 0; ai < 2; ++ai)
#pragma unroll
                        for (int m = 0; m < 4; ++m) {
                            const unsigned row = rowb + ai * 128 + m * 16;
                            GST16(ws + W_G, (row * 768 + col) * 2, pack8(acc[ai][bj][m][0], acc[ai][bj][m][1]));
                            EPI_FENCE();
                        }
                }
            }
        } else if (mode == EM_HLOC) {
            EPI_COORDS();
#pragma unroll
            for (int ai = 0; ai < 2; ++ai)
#pragma unroll
                for (int m = 0; m < 4; ++m) {
                    const unsigned row = rowb + ai * 128 + m * 16;
                    const unsigned o = (((((unsigned)u.bz & 3u) * 16u + ((unsigned)u.bz >> 2)) * 1024 + row) * 128 + colw) * 4;
                    GSTF4(ws + W_HLOC, o, acc[ai][0][m][0]); GSTF4(ws + W_HLOC, o + 16, acc[ai][0][m][1]);
                }
        } else if (mode == EM_YSSM) {
            EPI_COORDS();
            const unsigned g = u.bz;
            const float* dskip = Pq->in[I_SD] + l * 256;
#define Y_OFF(p_, q_, m_) (((g * 1024 + rowb + (p_) * 128 + (m_) * 16) * 1152 + 256 * u.pn + 128 * (q_) + colw) * 2)
            u32x4 buf[2][4];
#pragma unroll
            for (int m = 0; m < 4; ++m) buf[0][m] = GLD16(ws + W_U2, Y_OFF(0, 0, m));
#pragma unroll
            for (int bt = 0; bt < 4; ++bt) {
                const int bj = bt >> 1, ai = bt & 1;
                const unsigned col = 256 * u.pn + 128 * bj + colw, t = col >> 4, ch0 = col & 15;
                const f32x4 d0 = *(const f32x4*)(dskip + g * 16 + ch0), d1 = *(const f32x4*)(dskip + g * 16 + ch0 + 4);
                if (bt < 3) {
#pragma unroll
                    for (int m = 0; m < 4; ++m) buf[(bt + 1) & 1][m] = GLD16(ws + W_U2, Y_OFF((bt + 1) & 1, (bt + 1) >> 1, m));
                }
                EPI_FENCE();
#pragma unroll
                for (int m = 0; m < 4; ++m) {
                    const unsigned row = rowb + ai * 128 + m * 16;
                    f32x4 u0, u1; unpack8(buf[bt & 1][m], u0, u1);
                    f32x4 y0 = acc[ai][bj][m][0] + d0 * u0, y1 = acc[ai][bj][m][1] + d1 * u1;
#pragma unroll
                    for (int e = 0; e < 4; ++e) { y0[e] = gelu_tanh(y0[e]); y1[e] = gelu_tanh(y1[e]); }
                    GST16(ws + W_Z, ((row * 64 + t) * 256 + g * 16 + ch0) * 2, pack8(y0, y1));
                }
                EPI_FENCE();
            }
#undef Y_OFF
        } else if (mode == EM_GLU) {
            EPI_COORDS();
#define Z_OFF(p_, q_, m_) (((rowb + (p_) * 128 + (m_) * 16) * 256 + 128 * (q_) + colw) * 2)
            u32x4 buf[2][4];
#pragma unroll
            for (int m = 0; m < 4; ++m) buf[0][m] = GLD16(ws + W_Z, Z_OFF(0, 0, m));
#pragma unroll
            for (int bt = 0; bt < 4; ++bt) {
                const int bj = bt >> 1, ai = bt & 1;
                if (bt < 3) {
#pragma unroll
                    for (int m = 0; m < 4; ++m) buf[(bt + 1) & 1][m] = GLD16(ws + W_Z, Z_OFF((bt + 1) & 1, (bt + 1) >> 1, m));
                }
                EPI_FENCE();
#pragma unroll
                for (int m = 0; m < 4; ++m) {
                    const unsigned row = rowb + ai * 128 + m * 16;
                    f32x4 z0, z1; unpack8(buf[bt & 1][m], z0, z1);
                    f32x4 a0 = acc[ai][bj][m][0], a1 = acc[ai][bj][m][1];
#pragma unroll
                    for (int e = 0; e < 4; ++e) { a0[e] = z0[e] * sigmoidf_(a0[e]); a1[e] = z1[e] * sigmoidf_(a1[e]); }
                    GST16(ws + W_MIX, (row * 1024 + 512 + 128 * bj + colw) * 2, pack8(a0, a1));
                }
                EPI_FENCE();
            }
#undef Z_OFF
        } else if (mode == EM_RES) {
            EPI_COORDS();
#define RES_OFF(p_, q_, m_) (((rowb + (p_) * 128 + (m_) * 16) * 1024 + 256 * u.pn + 128 * (q_) + colw) * 2)
            if (sub == 0) {
                const float* gp = l ? Pq->in[I_LN2G] + (l - 1) * 1024 : (const float*)(ws + W_ONE);
                const float* bp = l ? Pq->in[I_LN2B] + (l - 1) * 1024 : (const float*)(ws + W_ONE) + 1024;
                u32x4 buf[2][4];
#pragma unroll
                for (int m = 0; m < 4; ++m) buf[0][m] = GLD16(ws + W_XV, RES_OFF(0, 0, m));
#pragma unroll
                for (int bt = 0; bt < 4; ++bt) {
                    const int bj = bt >> 1, ai = bt & 1;
                    const unsigned col = 256 * u.pn + 128 * bj + colw;
                    const f32x4 g0 = *(const f32x4*)(gp + col), g1 = *(const f32x4*)(gp + col + 4), b0 = *(const f32x4*)(bp + col), b1 = *(const f32x4*)(bp + col + 4);
                    if (bt < 3) {
#pragma unroll
                        for (int m = 0; m < 4; ++m) buf[(bt + 1) & 1][m] = GLD16(ws + W_XV, RES_OFF((bt + 1) & 1, (bt + 1) >> 1, m));
                    }
                    EPI_FENCE();
#pragma unroll
                    for (int m = 0; m < 4; ++m) {
                        float mn, rs; EPI_RSP(ai, m, mn, rs);
                        f32x4 x0, x1; unpack8(buf[bt & 1][m], x0, x1);
                        x0 = (x0 - mn) * rs * g0 + b0; x1 = (x1 - mn) * rs * g1 + b1;
                        GST16(ws + W_XV, RES_OFF(ai, bj, m), pack8(x0 * ALPHA + acc[ai][bj][m][0], x1 * ALPHA + acc[ai][bj][m][1]));
                    }
                    EPI_FENCE();
                }
            } else {
                LAS float* red = (LAS float*)(unsigned)LDS_RED;
                u32x4 buf[2][4]; float s1[4], s2[4];
#pragma unroll
                for (int m = 0; m < 4; ++m) buf[0][m] = GLD16(ws + W_XV, RES_OFF(0, 0, m));
#pragma unroll
                for (int bt = 0; bt < 4; ++bt) {
                    const int ai = bt >> 1, bj = bt & 1;
                    if (bt < 3) {
#pragma unroll
                        for (int m = 0; m < 4; ++m) buf[(bt + 1) & 1][m] = GLD16(ws + W_XV, RES_OFF((bt + 1) >> 1, (bt + 1) & 1, m));
                    }
                    EPI_FENCE();
#pragma unroll
                    for (int m = 0; m < 4; ++m) {
                        f32x4 x0, x1; unpack8(buf[bt & 1][m], x0, x1);
                        const u32x4 w = pack8(x0 * ALPHA + acc[ai][bj][m][0], x1 * ALPHA + acc[ai][bj][m][1]);
                        GST16(ws + W_XV, RES_OFF(ai, bj, m), w);
                        f32x4 r0, r1; unpack8(w, r0, r1);
                        const float a = ((r0[0] + r0[1]) + (r0[2] + r0[3])) + ((r1[0] + r1[1]) + (r1[2] + r1[3]));
                        const float b = ((r0[0] * r0[0] + r0[1] * r0[1]) + (r0[2] * r0[2] + r0[3] * r0[3])) + ((r1[0] * r1[0] + r1[1] * r1[1]) + (r1[2] * r1[2] + r1[3] * r1[3]));
                        if (bj == 0) { s1[m] = a; s2[m] = b; } else { s1[m] += a; s2[m] += b; }
                    }
                    if (bj == 1) {
#pragma unroll
                        for (int m = 0; m < 4; ++m) {
                            float a = s1[m], b = s2[m];
                            a = xsum32(xsum16(a)); b = xsum32(xsum16(b));
                            if (fq_ == 0) { const int ri = wc * 256 + ai * 128 + wr * 64 + m * 16 + fr_; red[2 * ri] = a; red[2 * ri + 1] = b; }
                        }
                    }
                    EPI_FENCE();
                }
                asm volatile("s_waitcnt lgkmcnt(0)" ::: "memory"); __builtin_amdgcn_s_barrier(); asm volatile("" ::: "memory");
                { int t3 = threadIdx.x; asm volatile("" : "+v"(t3));
                  if (t3 < 256) { float a = 0.f, b = 0.f;
#pragma unroll
                      for (int q = 0; q < 4; ++q) { a += red[2 * (q * 256 + t3)]; b += red[2 * (q * 256 + t3) + 1]; }
                      typedef float f32x2v __attribute__((ext_vector_type(2)));
                      *(f32x2v*)(ws + W_STA + ((unsigned)(u.pm * 256 + t3) * 4u + u.pn) * 8u) = (f32x2v){a, b}; } }
            }
#undef RES_OFF
        } else {
            EPI_COORDS();
            const bool smp = u.pm >= NTP;
            const int R0t = smp ? (MP + 248 * (u.pm - NTP) - 2) : (248 * u.pm - 2);
            const int lim = smp ? MT : MP;
            const float* cachef = Pq->in[I_CFF];
#pragma unroll
            for (int n = 0; n < 2; ++n) {
                EPI_FENCE();
                const unsigned f0 = 128 * u.pn + colw + 4 * n;
                const LAS f32x4* cwp = (const LAS f32x4*)(unsigned)(LDS_RED + par * 4096 + (8 * wc + 2 * fq_ + n) * 128);
                const f32x4 wg0 = cwp[0], wg1 = cwp[1], wg2 = cwp[2], wv0 = cwp[3], wv1 = cwp[4], wv2 = cwp[5], bg = cwp[6], bv = cwp[7];
#pragma unroll
                for (int ai = 0; ai < 2; ++ai) {
                    const int Rb = R0t + 62 * (2 * ai + wr);
#pragma unroll
                    for (int m = 0; m < 4; ++m) {
                        const int w = 16 * m + fr_, R = Rb + w;
                        const f32x4 g0 = acc[ai][0][m][n], v0 = acc[ai][1][m][n];
                        const f32x4 gp = acc[ai][0][m ? m - 1 : 0][n], vp = acc[ai][1][m ? m - 1 : 0][n];
                        f32x4 g1, g2, v1, v2;
#pragma unroll
                        for (int e = 0; e < 4; ++e) { g1[e] = shift1(g0[e], gp[e]); g2[e] = shift2(g0[e], gp[e]); v1[e] = shift1(v0[e], vp[e]); v2[e] = shift2(v0[e], vp[e]); }
                        const bool ok = (w >= 2) && (R < lim);
                        if (!smp) {
                            const int sq = R & 2047;
                            if (sq == 0) { g1 = (f32x4){0.f, 0.f, 0.f, 0.f}; v1 = g1; }
                            if (sq <= 1) { g2 = (f32x4){0.f, 0.f, 0.f, 0.f}; v2 = g2; }
                        } else if (ok) {
                            const int t = (R - MP) & 31, b = (R - MP) >> 5;
                            if (t <= 1) {
                                const float* c1 = cachef + ((size_t)(l * 16 + b) * 2 + 1) * 4096 + f0;
                                const f32x4 cg = *(const f32x4*)c1, cv = *(const f32x4*)(c1 + 2048);
                                if (t == 0) { g1 = cg; v1 = cv; g2 = *(const f32x4*)(c1 - 4096); v2 = *(const f32x4*)(c1 - 4096 + 2048); }
                                else { g2 = cg; v2 = cv; }
                            }
                        }
                        const f32x4 gg = wg0 * g2 + wg1 * g1 + wg2 * g0 + bg, vv = wv0 * v2 + wv1 * v1 + wv2 * v0 + bv;
                        f32x4 h;
#pragma unroll
                        for (int e = 0; e < 4; ++e) h[e] = gg[e] * sigmoidf_(gg[e]) * vv[e];
                        if (ok) {
                            u32x2 hw; hw.x = cvt_pk_bf16(h[0], h[1]); hw.y = cvt_pk_bf16(h[2], h[3]);
                            *(u32x2*)((unsigned char*)out + ((unsigned)R * 2048u + f0) * 2u) = hw;
                            if (!smp) {
                                const int sq = R & 2047;
                                if (sq >= 2046) { const unsigned o = (((l * 32 + (R >> 11)) * 2 + (sq - 2046)) * 4096 + f0) * 4; GSTF4(out + O_FFP, o, g0); GSTF4(out + O_FFP, o + 8192, v0); }
                            } else {
                                const int t = (R - MP) & 31, b = (R - MP) >> 5;
                                if (t >= 30) { const unsigned o = (((l * 16 + b) * 2 + (t - 30)) * 4096 + f0) * 4; GSTF4(out + O_FFS, o, g0); GSTF4(out + O_FFS, o + 8192, v0); }
                            }
                        }
                        EPI_FENCE();
                    }
                }
            }
        }
    }
};

struct Ctx { int tid, lane, wave, G, bid, gtid, NT, gw, NGW; };

__device__ __forceinline__ int ffperm(int n) { return n < 2048 ? ((n >> 7) << 8) + (n & 127) : (((n - 2048) >> 7) << 8) + 128 + ((n - 2048) & 127); }
__device__ __forceinline__ void transpose_item(const float* W, int K, int N, bf16_t* WT, LAS float* scr, int item, int lane, bool ffp = false, const float* gk = nullptr) {
    const int nblk = N / 32, kb = item / nblk, nb = item % nblk, k0 = 64 * kb, n0 = 32 * nb;
#pragma unroll 8
    for (int i = 0; i < 32; ++i) { const int kk = 2 * i + (lane >> 5); float wv = W[(size_t)(k0 + kk) * N + n0 + (lane & 31)]; if (gk) wv *= gk[k0 + kk]; scr[kk * 33 + (lane & 31)] = wv; }
    asm volatile("s_waitcnt lgkmcnt(0)" ::: "memory");
    const int c = lane & 7;
#pragma unroll
    for (int j = 0; j < 4; ++j) { const int n = (lane >> 3) + 8 * j; const LAS float* s = scr + (8 * c) * 33 + n;
        u32x4 o; o.x = cvt_pk_bf16(s[0 * 33], s[1 * 33]); o.y = cvt_pk_bf16(s[2 * 33], s[3 * 33]); o.z = cvt_pk_bf16(s[4 * 33], s[5 * 33]); o.w = cvt_pk_bf16(s[6 * 33], s[7 * 33]);
        const int nd = ffp ? ffperm(n0 + n) : (n0 + n);
        *(u32x4*)(WT + (size_t)nd * K + k0 + 8 * c) = o; }
    asm volatile("s_waitcnt lgkmcnt(0)" ::: "memory");
}

__device__ __forceinline__ void ln_in_load(const float* xrow, f32x4 (&v)[4], int lane) {
#pragma unroll
    for (int j = 0; j < 2; ++j) { v[2 * j] = *(const f32x4*)(xrow + lane * 8 + 512 * j); v[2 * j + 1] = *(const f32x4*)(xrow + lane * 8 + 512 * j + 4); }
}
__device__ __forceinline__ void ln_in_compute(f32x4 (&v)[4], const float* g, const float* b, bf16_t* orow, int lane) {
    float s = 0.f;
#pragma unroll
    for (int j = 0; j < 4; ++j) s += (v[j][0] + v[j][1]) + (v[j][2] + v[j][3]);
    const float mean = wave_sum(s) * (1.f / 1024.f); float q = 0.f;
#pragma unroll
    for (int j = 0; j < 4; ++j) { v[j] = v[j] - mean; q += (v[j][0] * v[j][0] + v[j][1] * v[j][1]) + (v[j][2] * v[j][2] + v[j][3] * v[j][3]); }
    const float rstd = 1.f / sqrtf(wave_sum(q) * (1.f / 1024.f) + LN_EPS);
#pragma unroll
    for (int j = 0; j < 2; ++j) {
        const int c = lane * 8 + 512 * j;
        const f32x4 g0 = *(const f32x4*)(g + c), g1 = *(const f32x4*)(g + c + 4), b0 = *(const f32x4*)(b + c), b1 = *(const f32x4*)(b + c + 4);
        *(u32x4*)(orow + c) = pack8(v[2 * j] * rstd * g0 + b0, v[2 * j + 1] * rstd * g1 + b1);
    }
}

__device__ __forceinline__ void ln_phase(const Ctx& C, unsigned char* ws, const float* g, const float* b, float* yout) {
    bf16_t* xv = (bf16_t*)(ws + W_XV);
    f32x4 gg[4], bb[4];
#pragma unroll
    for (int j = 0; j < 2; ++j) { const int c = C.lane * 8 + 512 * j; gg[2 * j] = *(const f32x4*)(g + c); gg[2 * j + 1] = *(const f32x4*)(g + c + 4); bb[2 * j] = *(const f32x4*)(b + c); bb[2 * j + 1] = *(const f32x4*)(b + c + 4); }
    for (int row0 = C.gw; row0 < MT; row0 += 4 * C.NGW) {
        u32x4 w[4][2];
#pragma unroll
        for (int k = 0; k < 4; ++k) { const int row = row0 + k * C.NGW;
            if (row < MT) {
#pragma unroll
                for (int j = 0; j < 2; ++j) w[k][j] = *(const u32x4*)(xv + (size_t)row * 1024 + C.lane * 8 + 512 * j);
            } else { w[k][0] = (u32x4){0u, 0u, 0u, 0u}; w[k][1] = w[k][0]; } }
#pragma unroll
        for (int k = 0; k < 4; ++k) { const int row = row0 + k * C.NGW;
            if (row < MT) {
                bf16_t* xr = xv + (size_t)row * 1024;
                f32x4 v[4]; float s = 0.f;
#pragma unroll
                for (int j = 0; j < 2; ++j) unpack8(w[k][j], v[2 * j], v[2 * j + 1]);
#pragma unroll
                for (int j = 0; j < 4; ++j) s += (v[j][0] + v[j][1]) + (v[j][2] + v[j][3]);
                const float mean = wave_sum(s) * (1.f / 1024.f); float q = 0.f;
#pragma unroll
                for (int j = 0; j < 4; ++j) { v[j] = v[j] - mean; q += (v[j][0] * v[j][0] + v[j][1] * v[j][1]) + (v[j][2] * v[j][2] + v[j][3] * v[j][3]); }
                const float rstd = 1.f / sqrtf(wave_sum(q) * (1.f / 1024.f) + LN_EPS);
#pragma unroll
                for (int j = 0; j < 4; ++j) v[j] = v[j] * rstd * gg[j] + bb[j];
#pragma unroll
                for (int j = 0; j < 2; ++j) *(u32x4*)(xr + C.lane * 8 + 512 * j) = pack8(v[2 * j], v[2 * j + 1]);
                if (yout) {
#pragma unroll
                    for (int j = 0; j < 2; ++j) { float* p = yout + (size_t)row * 1024 + C.lane * 8 + 512 * j; *(f32x4*)p = v[2 * j]; *(f32x4*)(p + 4) = v[2 * j + 1]; }
                }
            } }
    }
}

__device__ __forceinline__ void ssm_T_phase(const Ctx& C, int l, LAS unsigned char* lds) {
    const CParams Pp = get_params();
    LAS float* Wr = (LAS float*)lds; LAS float* Wi = Wr + 64 * 17;
    float* T = (float*)(Pp->ws + W_SSMT);
    for (int unit = C.bid; unit < 1024; unit += C.G) {
        const int g = unit >> 6, tau = unit & 63;
        const int p = C.tid >> 3, c2 = (C.tid & 7) * 2;
        const float lr = Pp->in[I_LAMRE][(l * 16 + g) * 64 + p], li = Pp->in[I_LAMIM][(l * 16 + g) * 64 + p], dt = __expf(Pp->in[I_LOGDT][l * 16 + g]);
        float er, ei, cr, ci; cpow_exp(lr, li, dt, (float)tau, er, ei); ssm_cf(lr, li, dt, cr, ci);
        const float fr_ = er * cr - ei * ci, fi_ = er * ci + ei * cr;
#pragma unroll
        for (int k = 0; k < 2; ++k) {
            const size_t bi = ((size_t)(l * 16 + g) * 64 + p) * 16 + c2 + k;
            const float br = Pp->in[I_BRE][bi], bim = Pp->in[I_BIM][bi];
            Wr[p * 17 + c2 + k] = fr_ * br - fi_ * bim; Wi[p * 17 + c2 + k] = fr_ * bim + fi_ * br;
        }
        __syncthreads();
        if (C.tid < 256) {
            const int co = C.tid >> 4, ci2 = C.tid & 15;
            const float* cre = Pp->in[I_CRE] + ((size_t)(l * 16 + g) * 16 + co) * 64; const float* cim = Pp->in[I_CIM] + ((size_t)(l * 16 + g) * 16 + co) * 64;
            float a = 0.f;
            for (int pp = 0; pp < 64; ++pp) a += cre[pp] * Wr[pp * 17 + ci2] - cim[pp] * Wi[pp * 17 + ci2];
            T[((size_t)(g * 64 + tau) * 16 + co) * 16 + ci2] = a;
        }
        __syncthreads();
    }
}

__device__ __forceinline__ void ssm_fill_phase(const Ctx& C, int l) {
    const CParams Pp = get_params();
    const float* T = (const float*)(Pp->ws + W_SSMT);
    bf16_t* YK = (bf16_t*)(Pp->ws + W_YK); bf16_t* HM = (bf16_t*)(Pp->ws + W_HM);
    for (int item = C.gtid; item < 16 * 1024 * 128; item += C.NT) {
        const int half = item & 1, s = (item >> 1) & 63, rowi = item >> 7, g = rowi >> 10, t = (rowi >> 4) & 63, co = rowi & 15;
        u32x4 w = (u32x4){0u, 0u, 0u, 0u};
        if (s <= t) { const float* tp = T + ((size_t)(g * 64 + (t - s)) * 16 + co) * 16 + half * 8; w = pack8(*(const f32x4*)tp, *(const f32x4*)(tp + 4)); }
        *(u32x4*)(YK + (size_t)rowi * 1152 + s * 16 + half * 8) = w;
    }
    for (int item = C.gtid; item < 16 * 1024 * 64; item += C.NT) {
        const int p = item & 63, rowi = item >> 6, g = rowi >> 10, t = (rowi >> 4) & 63, co = rowi & 15;
        const float lr = Pp->in[I_LAMRE][(l * 16 + g) * 64 + p], li = Pp->in[I_LAMIM][(l * 16 + g) * 64 + p], dt = __expf(Pp->in[I_LOGDT][l * 16 + g]);
        float er, ei; cpow_exp(lr, li, dt, (float)(t + 1), er, ei);
        const size_t ci_ = ((size_t)(l * 16 + g) * 16 + co) * 64 + p;
        const float cr = Pp->in[I_CRE][ci_], ci = Pp->in[I_CIM][ci_];
        YK[(size_t)rowi * 1152 + 1024 + p] = f2bf(cr * er - ci * ei);
        YK[(size_t)rowi * 1152 + 1088 + p] = f2bf(-(cr * ei + ci * er));
    }
    for (int item = C.gtid; item < 16 * 128 * 64; item += C.NT) {
        const int s = item & 63, pr = (item >> 6) & 127, g = item >> 13, p = pr & 63, part = pr >> 6;
        const float lr = Pp->in[I_LAMRE][(l * 16 + g) * 64 + p], li = Pp->in[I_LAMIM][(l * 16 + g) * 64 + p], dt = __expf(Pp->in[I_LOGDT][l * 16 + g]);
        float er, ei, cr, ci; cpow_exp(lr, li, dt, (float)(63 - s), er, ei); ssm_cf(lr, li, dt, cr, ci);
        const float fr_ = er * cr - ei * ci, fi_ = er * ci + ei * cr;
        const float* br = Pp->in[I_BRE] + ((size_t)(l * 16 + g) * 64 + p) * 16; const float* bi = Pp->in[I_BIM] + ((size_t)(l * 16 + g) * 64 + p) * 16;
        f32x4 o[4];
#pragma unroll
        for (int q = 0; q < 4; ++q) {
            const f32x4 b_r = *(const f32x4*)(br + 4 * q), b_i = *(const f32x4*)(bi + 4 * q);
            o[q] = part ? (b_i * fr_ + b_r * fi_) : (b_r * fr_ - b_i * fi_);
        }
        bf16_t* dst = HM + ((size_t)g * 256 + pr) * 1024 + s * 16;
        *(u32x4*)dst = pack8(o[0], o[1]); *(u32x4*)(dst + 8) = pack8(o[2], o[3]);
    }
    for (int item = C.gtid; item < 16 * 128 * 128; item += C.NT) {
        const int c8 = item & 127, r = (item >> 7) & 127, g = item >> 14;
        *(u32x4*)(HM + ((size_t)g * 256 + 128 + r) * 1024 + c8 * 8) = (u32x4){0u, 0u, 0u, 0u};
    }
}

__device__ __forceinline__ void convert_layer(const Ctx& C, LAS unsigned char* lds, int l) {
    const CParams Pp = get_params();
    LAS float* scr = (LAS float*)(lds + C.wave * 16384);
    constexpr int I_A = 16 * 80, I_B = 16 * 32, I_C = 16 * 128, I_D = 32 * 32, I_E = 4 * 8, I_L = I_A + I_B + I_C + I_D + I_E;
    for (int it = C.gw; it < I_L; it += C.NGW) {
        int r = it;
        if (r < I_A) { transpose_item(Pp->in[I_WIN] + (size_t)l * DM * NPROJ, DM, NPROJ, (bf16_t*)(Pp->ws + W_WIN) + (size_t)l * NPROJ * DM, scr, r, C.lane, false, l ? Pp->in[I_LN2G] + (l - 1) * 1024 : nullptr); continue; } r -= I_A;
        if (r < I_B) { transpose_item(Pp->in[I_WOUT] + (size_t)l * DM * DM, DM, DM, (bf16_t*)(Pp->ws + W_WOUT) + (size_t)l * DM * DM, scr, r, C.lane); continue; } r -= I_B;
        if (r < I_C) { transpose_item(Pp->in[I_WFFI] + (size_t)l * DM * DFF2, DM, DFF2, (bf16_t*)(Pp->ws + W_WFFI) + (size_t)l * DFF2 * DM, scr, r, C.lane, true); continue; } r -= I_C;
        if (r < I_D) { transpose_item(Pp->in[I_WFFO] + (size_t)l * DFF * DM, DFF, DM, (bf16_t*)(Pp->ws + W_WFFO) + (size_t)l * DM * DFF, scr, r, C.lane); continue; } r -= I_D;
        transpose_item(Pp->in[I_WGLU] + (size_t)l * 65536, 256, 256, (bf16_t*)(Pp->ws + W_WGLU) + (size_t)l * 65536, scr, r, C.lane);
    }
    for (int item = C.gtid; item < 16 * 512 * 8 * 8; item += C.NT) {
        const int d8 = item & 7, h = (item >> 3) & 7, j = (item >> 6) & 511, b = (item >> 15) & 15;
        const float* src = Pp->in[I_CK] + ((((size_t)(l * 16 + b) * 512 + j) * 8 + h) * 64 + d8 * 8);
        *(u32x4*)((bf16_t*)(Pp->ws + W_KS) + ((size_t)(l * 128 + b * 8 + h) * 544 + j) * 64 + d8 * 8) = pack8(*(const f32x4*)src, *(const f32x4*)(src + 4));
    }
    for (int item = C.gtid; item < 128 * 16 * 4 * 64; item += C.NT) {
        const int ln = item & 63, db = (item >> 6) & 3, st = (item >> 8) & 15, bh = (item >> 12) & 127;
        const int frv = ln & 15, fqv = ln >> 4, d = 16 * db + frv, b = bh >> 3, h = bh & 7;
        float v[8];
#pragma unroll
        for (int i = 0; i < 8; ++i) { const int key = 32 * st + (i < 4 ? 4 * fqv + i : 16 + 4 * fqv + i - 4);
            v[i] = Pp->in[I_CV][(((size_t)(l * 16 + b) * 512 + key) * 8 + h) * 64 + d]; }
        u32x4 w; w.x = cvt_pk_bf16(v[0], v[1]); w.y = cvt_pk_bf16(v[2], v[3]); w.z = cvt_pk_bf16(v[4], v[5]); w.w = cvt_pk_bf16(v[6], v[7]);
        *(u32x4*)((bf16_t*)(Pp->ws + W_VFS) + ((((size_t)(l * 128 + bh) * 18 + st) * 4 + db) * 64 + ln) * 8) = w;
    }
}

__device__ __forceinline__ void prologue_phase(const Ctx& C, LAS unsigned char* lds) {
    const CParams Pp = get_params();
    const int nconv = (C.G > 8) ? 1 : NL;
    for (int l = 0; l < nconv; ++l) convert_layer(C, lds, l);
    for (int item = C.gtid; item < NL * 512 * 8; item += C.NT) {
        const int j = item & 7, grp = (item >> 3) & 511, l = item >> 12;
        const float* src = j < 3 ? Pp->in[I_FCW] + (size_t)(l * 3 + j) * 4096 + grp * 4 : j < 6 ? Pp->in[I_FCW] + (size_t)(l * 3 + j - 3) * 4096 + 2048 + grp * 4
                         : j == 6 ? Pp->in[I_FCB] + (size_t)l * 4096 + grp * 4 : Pp->in[I_FCB] + (size_t)l * 4096 + 2048 + grp * 4;
        *(f32x4*)(Pp->ws + W_CW + (size_t)item * 16) = *(const f32x4*)src;
    }
    for (int item = C.gtid; item < NL * 2560 * 16; item += C.NT) {
        const int n = item % 2560, kc = (item / 2560) & 15, l = item / (2560 * 16);
        const float* W = Pp->in[I_WIN] + (size_t)l * DM * NPROJ + (size_t)kc * 64 * NPROJ + n;
        const float* gk = Pp->in[I_LN2G] + (l ? l - 1 : 0) * 1024 + kc * 64;
        const float* bk = Pp->in[I_LN2B] + (l ? l - 1 : 0) * 1024 + kc * 64;
        float cs = 0.f, bs = 0.f;
#pragma unroll 16
        for (int k = 0; k < 64; ++k) { const float w = W[(size_t)k * NPROJ]; const float wf = l ? w * gk[k] : w; cs += bf1(f2bf(wf)); bs += l ? bk[k] * w : 0.f; }
        float* dst = (float*)(Pp->ws + W_CSP) + (size_t)item * 2;
        dst[0] = cs; dst[1] = bs;
    }
    for (int item = C.gtid; item < MT * 4; item += C.NT) { typedef float f32x2v __attribute__((ext_vector_type(2))); *(f32x2v*)(Pp->ws + W_STA + (size_t)item * 8) = (f32x2v){0.f, 256.f * (1.f - LN_EPS)}; }
    for (int item = C.gtid; item < 2048; item += C.NT) ((float*)(Pp->ws + W_ONE))[item] = item < 1024 ? 1.f : 0.f;
    for (int row0 = C.gw; row0 < MT; row0 += 3 * C.NGW) {
        f32x4 va[4], vb[4], vc[4];
        const int r1 = row0 + C.NGW, r2 = row0 + 2 * C.NGW;
        ln_in_load(row0 < MP ? Pp->in[I_XP] + (size_t)row0 * 1024 : Pp->in[I_XS] + (size_t)(row0 - MP) * 1024, va, C.lane);
        if (r1 < MT) ln_in_load(r1 < MP ? Pp->in[I_XP] + (size_t)r1 * 1024 : Pp->in[I_XS] + (size_t)(r1 - MP) * 1024, vb, C.lane);
        if (r2 < MT) ln_in_load(r2 < MP ? Pp->in[I_XP] + (size_t)r2 * 1024 : Pp->in[I_XS] + (size_t)(r2 - MP) * 1024, vc, C.lane);
        ln_in_compute(va, Pp->in[I_LNG], Pp->in[I_LNB], (bf16_t*)(Pp->ws + W_XV) + (size_t)row0 * 1024, C.lane);
        if (r1 < MT) ln_in_compute(vb, Pp->in[I_LNG], Pp->in[I_LNB], (bf16_t*)(Pp->ws + W_XV) + (size_t)r1 * 1024, C.lane);
        if (r2 < MT) ln_in_compute(vc, Pp->in[I_LNG], Pp->in[I_LNB], (bf16_t*)(Pp->ws + W_XV) + (size_t)r2 * 1024, C.lane);
    }
}

__device__ __forceinline__ void attn_unit(const bf16_t* __restrict__ Q, const bf16_t* __restrict__ K, const bf16_t* __restrict__ VFp,
                                          int nsteps, int dist0, const LAS float* bias, bf16_t* out, int nqb, int lane) {
    const int fr = lane & 15, fq = lane >> 4;
    bf16x8 qf[4][2];
#pragma unroll
    for (int qb = 0; qb < 4; ++qb)
#pragma unroll
        for (int ds = 0; ds < 2; ++ds) {
            if (qb < nqb) qf[qb][ds] = *(const bf16x8*)(Q + (size_t)(16 * qb + fr) * 64 + 32 * ds + 8 * fq);
            else qf[qb][ds] = (bf16x8){0, 0, 0, 0, 0, 0, 0, 0};
        }
    f32x4 o[4][4]; float mrow[4], lrow[4];
#pragma unroll
    for (int a = 0; a < 4; ++a) { mrow[a] = -1e30f; lrow[a] = 0.f;
#pragma unroll
        for (int b = 0; b < 4; ++b) o[a][b] = (f32x4){0.f, 0.f, 0.f, 0.f}; }
    bf16x8 kf[2][2];
    {
        const bf16_t* kp = K + (size_t)fr * 64 + 8 * fq;
#pragma unroll
        for (int kb = 0; kb < 2; ++kb)
#pragma unroll
            for (int ds = 0; ds < 2; ++ds) kf[kb][ds] = *(const bf16x8*)(kp + kb * 1024 + ds * 32);
    }
    const float bfar = bias[191];
    for (int st = 0; st < nsteps; ++st) {
        bf16x8 kn[2][2], vf[4];
        const bf16_t* vp = VFp + (size_t)st * 2048 + lane * 8;
#pragma unroll
        for (int db = 0; db < 4; ++db) vf[db] = *(const bf16x8*)(vp + db * 512);
        if (st + 1 < nsteps) {
            const bf16_t* kp = K + (size_t)(32 * (st + 1) + fr) * 64 + 8 * fq;
#pragma unroll
            for (int kb = 0; kb < 2; ++kb)
#pragma unroll
                for (int ds = 0; ds < 2; ++ds) kn[kb][ds] = *(const bf16x8*)(kp + kb * 1024 + ds * 32);
        } else {
#pragma unroll
            for (int kb = 0; kb < 2; ++kb)
#pragma unroll
                for (int ds = 0; ds < 2; ++ds) kn[kb][ds] = kf[kb][ds];
        }
        f32x4 s[2][4];
#pragma unroll
        for (int kb = 0; kb < 2; ++kb)
#pragma unroll
            for (int qb = 0; qb < 4; ++qb) {
                s[kb][qb] = __builtin_amdgcn_mfma_f32_16x16x32_bf16(kf[kb][0], qf[qb][0], (f32x4){0.f, 0.f, 0.f, 0.f}, 0, 0, 0);
                s[kb][qb] = __builtin_amdgcn_mfma_f32_16x16x32_bf16(kf[kb][1], qf[qb][1], s[kb][qb], 0, 0, 0);
            }
        const int dbase = dist0 + fr - 32 * st - 4 * fq;
        const bool far = (dist0 - 32 * st - 31) >= 128;
#pragma unroll
        for (int qb = 0; qb < 4; ++qb) {
            float mx = -1e30f;
            if (far) {
#pragma unroll
                for (int kb = 0; kb < 2; ++kb)
#pragma unroll
                    for (int r = 0; r < 4; ++r) { const float v = s[kb][qb][r] + bfar; s[kb][qb][r] = v; mx = fmaxf(mx, v); }
            } else {
#pragma unroll
                for (int kb = 0; kb < 2; ++kb)
#pragma unroll
                    for (int r = 0; r < 4; ++r) {
                        int d = dbase + 16 * qb - 16 * kb - r; d = d < -63 ? -63 : d; d = d > 128 ? 128 : d;
                        const float v = s[kb][qb][r] + bias[d + 63]; s[kb][qb][r] = v; mx = fmaxf(mx, v);
                    }
            }
            mx = xmax32(xmax16(mx));
            if (__any(mx > mrow[qb])) {
                const float mnew = fmaxf(mrow[qb], mx), al = fexp2(mrow[qb] - mnew); mrow[qb] = mnew; lrow[qb] *= al;
#pragma unroll
                for (int db = 0; db < 4; ++db) o[db][qb] = o[db][qb] * al;
            }
            const float mcur = mrow[qb];
            float ls = 0.f;
#pragma unroll
            for (int kb = 0; kb < 2; ++kb)
#pragma unroll
                for (int r = 0; r < 4; ++r) { const float p = fexp2(s[kb][qb][r] - mcur); s[kb][qb][r] = p; ls += p; }
            lrow[qb] += ls;
            u32x4 w; w.x = cvt_pk_bf16(s[0][qb][0], s[0][qb][1]); w.y = cvt_pk_bf16(s[0][qb][2], s[0][qb][3]); w.z = cvt_pk_bf16(s[1][qb][0], s[1][qb][1]); w.w = cvt_pk_bf16(s[1][qb][2], s[1][qb][3]);
            const bf16x8 pb = __builtin_bit_cast(bf16x8, w);
#pragma unroll
            for (int db = 0; db < 4; ++db) o[db][qb] = __builtin_amdgcn_mfma_f32_16x16x32_bf16(vf[db], pb, o[db][qb], 0, 0, 0);
        }
#pragma unroll
        for (int kb = 0; kb < 2; ++kb)
#pragma unroll
            for (int ds = 0; ds < 2; ++ds) kf[kb][ds] = kn[kb][ds];
    }
#pragma unroll
    for (int qb = 0; qb < 4; ++qb) {
        if (qb < nqb) {
            float lt = xsum32(xsum16(lrow[qb]));
            const float inv = 1.f / lt;
#pragma unroll
            for (int db = 0; db < 4; ++db) {
                const f32x4 v = o[db][qb] * inv; u32x2 w; w.x = cvt_pk_bf16(v[0], v[1]); w.y = cvt_pk_bf16(v[2], v[3]);
                *(u32x2*)(out + (size_t)(16 * qb + fr) * 1024 + 16 * db + 4 * fq) = w;
            }
        }
    }
}

__device__ __forceinline__ void sconv_phase(const Ctx& C, int l);
__device__ __forceinline__ void attn_phase(const Ctx& C, int l, LAS unsigned char* lds) {
    const CParams Pp = get_params();
    LAS float* bt = (LAS float*)lds;
    for (int i = C.tid; i < 8 * 192; i += 512) bt[i] = Pp->in[I_RELB][l * 1536 + i] * LOG2E;
    __syncthreads();
    const bf16_t* Qh = (const bf16_t*)(Pp->ws + W_QH); const bf16_t* Kh = (const bf16_t*)(Pp->ws + W_KH); const bf16_t* VF = (const bf16_t*)(Pp->ws + W_VF);
    bf16_t* mix = (bf16_t*)(Pp->ws + W_MIX);
    if (C.wave < 4) sconv_phase(C, l);
    for (int u = C.gw; u < 8192; u += C.NGW) {
        const int bh = u >> 5, c = ((u & 31) + 8 * (u >> 11)) & 31, b = bh >> 3, h = bh & 7;
        const int nkc = (c < 8 ? c : 8) + 1, m0 = b * 2048 + c * 64, k0 = m0 - (nkc - 1) * 64;
        attn_unit(Qh + ((size_t)h * MT + m0) * 64, Kh + ((size_t)h * MT + k0) * 64, VF + ((size_t)h * NCHK + (k0 >> 6)) * 4096,
                  2 * nkc, m0 - k0, bt + h * 192, mix + (size_t)m0 * 1024 + h * 64, 4, C.lane);
    }
    {
        const bool bal = (C.NGW == 2048);
        for (int us = bal ? (((C.gw & 15) == 0) ? (C.gw >> 4) : 128) : C.gw; us < 128; us += bal ? 128 : C.NGW) {
            const int b = us >> 3, h = us & 7;
            attn_unit(Qh + ((size_t)h * MT + MP + b * 32) * 64, (const bf16_t*)(Pp->ws + W_KS) + (size_t)(l * 128 + b * 8 + h) * 544 * 64,
                      (const bf16_t*)(Pp->ws + W_VFS) + (size_t)(l * 128 + b * 8 + h) * 18 * 2048, 17, 512, bt + h * 192,
                      mix + (size_t)(MP + b * 32) * 1024 + h * 64, 2, C.lane);
        }
    }
    if (C.wave >= 4) sconv_phase(C, l);
}

__device__ __forceinline__ void sconv_phase(const Ctx& C, int l) {
    const CParams Pp = get_params();
    const bf16_t* G = (const bf16_t*)(Pp->ws + W_G); bf16_t* mix = (bf16_t*)(Pp->ws + W_MIX);
    const int c = (C.gtid & 31) * 8;
    f32x4 w0[2], w1[2], w2[2], bs[2];
#pragma unroll
    for (int k = 0; k < 2; ++k) {
        w0[k] = *(const f32x4*)(Pp->in[I_SCW] + (size_t)(l * 3 + 0) * 256 + c + 4 * k); w1[k] = *(const f32x4*)(Pp->in[I_SCW] + (size_t)(l * 3 + 1) * 256 + c + 4 * k);
        w2[k] = *(const f32x4*)(Pp->in[I_SCW] + (size_t)(l * 3 + 2) * 256 + c + 4 * k); bs[k] = *(const f32x4*)(Pp->in[I_SCB] + (size_t)l * 256 + c + 4 * k);
    }
    for (int item = C.gtid; item < MT * 32; item += C.NT) {
        const int row = item >> 5;
        const bool smp = row >= MP; const int s = smp ? ((row - MP) & 31) : (row & 2047), b = smp ? ((row - MP) >> 5) : (row >> 11);
        const bf16_t* gr = G + (size_t)row * 768 + c;
        f32x4 gb0, gb1, a0, a1, x0, x1, i0[2], i1[2], i2[2];
        unpack8(*(const u32x4*)gr, gb0, gb1); unpack8(*(const u32x4*)(gr + 256), a0, a1); unpack8(*(const u32x4*)(gr + 512), x0, x1);
        i0[0] = a0 * x0; i0[1] = a1 * x1;
        if (s >= 1) { unpack8(*(const u32x4*)(gr - 768 + 256), a0, a1); unpack8(*(const u32x4*)(gr - 768 + 512), x0, x1); i1[0] = a0 * x0; i1[1] = a1 * x1; }
        else if (smp) { const float* cp = Pp->in[I_CSC] + ((size_t)(l * 16 + b) * 2 + 1) * 256 + c; i1[0] = *(const f32x4*)cp; i1[1] = *(const f32x4*)(cp + 4); }
        else { i1[0] = (f32x4){0.f, 0.f, 0.f, 0.f}; i1[1] = i1[0]; }
        if (s >= 2) { unpack8(*(const u32x4*)(gr - 2 * 768 + 256), a0, a1); unpack8(*(const u32x4*)(gr - 2 * 768 + 512), x0, x1); i2[0] = a0 * x0; i2[1] = a1 * x1; }
        else if (smp) { const float* cp = Pp->in[I_CSC] + ((size_t)(l * 16 + b) * 2 + s) * 256 + c; i2[0] = *(const f32x4*)cp; i2[1] = *(const f32x4*)(cp + 4); }
        else { i2[0] = (f32x4){0.f, 0.f, 0.f, 0.f}; i2[1] = i2[0]; }
        const f32x4 r0 = gb0 * (w0[0] * i2[0] + w1[0] * i1[0] + w2[0] * i0[0] + bs[0]);
        const f32x4 r1 = gb1 * (w0[1] * i2[1] + w1[1] * i1[1] + w2[1] * i0[1] + bs[1]);
        *(u32x4*)(mix + (size_t)row * 1024 + 768 + c) = pack8(r0, r1);
        if (!smp && s >= 2046) { float* p = Pp->out + O_SCP + ((size_t)(l * 32 + b) * 2 + (s - 2046)) * 256 + c; *(f32x4*)p = i0[0]; *(f32x4*)(p + 4) = i0[1]; }
        if (smp && s >= 30) { float* p = Pp->out + O_SCS + ((size_t)(l * 16 + b) * 2 + (s - 30)) * 256 + c; *(f32x4*)p = i0[0]; *(f32x4*)(p + 4) = i0[1]; }
    }
}

__device__ __forceinline__ void scan_phase(const Ctx& C, int l, LAS unsigned char* lds) {
    const CParams Pp = get_params();
    bf16_t* U2 = (bf16_t*)(Pp->ws + W_U2); const float* HL = (const float*)(Pp->ws + W_HLOC);
    {
        const int gw2 = C.wave * C.G + C.bid;
        for (int w = gw2; w < 512; w += C.NGW) {
            const int idx = w * 64 + C.lane, p = idx & 63, g = (idx >> 6) & 15, b = idx >> 10;
            const float lr = Pp->in[I_LAMRE][(l * 16 + g) * 64 + p], li = Pp->in[I_LAMIM][(l * 16 + g) * 64 + p], dt = __expf(Pp->in[I_LOGDT][l * 16 + g]);
            float ar, ai; cpow_exp(lr, li, dt, 64.f, ar, ai);
            float hr = 0.f, hi = 0.f;
#pragma unroll 8
            for (int c = 0; c < 32; ++c) {
                const size_t rowi = (size_t)g * 1024 + b * 32 + c;
                U2[rowi * 1152 + 1024 + p] = f2bf(hr); U2[rowi * 1152 + 1088 + p] = f2bf(hi);
                float xr = 0.f, xi = 0.f;
#pragma unroll
                for (int ks = 0; ks < 4; ++ks) { xr += HL[((size_t)ks * 16384 + rowi) * 128 + p]; xi += HL[((size_t)ks * 16384 + rowi) * 128 + 64 + p]; }
                const float nr = ar * hr - ai * hi + xr, ni = ar * hi + ai * hr + xi; hr = nr; hi = ni;
            }
            Pp->out[O_SRP + ((size_t)(l * 32 + b) * 16 + g) * 64 + p] = hr; Pp->out[O_SIP + ((size_t)(l * 32 + b) * 16 + g) * 64 + p] = hi;
        }
    }
    LAS float* us = (LAS float*)lds; LAS float* hsr = us + 512; LAS float* hsi = hsr + 32 * 65;
    const bf16_t* US = (const bf16_t*)(Pp->ws + W_US); bf16_t* Z = (bf16_t*)(Pp->ws + W_Z);
    for (int unit = C.bid; unit < 256; unit += C.G) {
        const int b = unit >> 4, g = unit & 15;
        { const int t = C.tid >> 4, c = C.tid & 15; us[C.tid] = bf1(US[(size_t)(b * 32 + t) * 256 + g * 16 + c]); }
        __syncthreads();
        if (C.tid < 64) {
            const int p = C.tid;
            const float lr = Pp->in[I_LAMRE][(l * 16 + g) * 64 + p], li = Pp->in[I_LAMIM][(l * 16 + g) * 64 + p], dt = __expf(Pp->in[I_LOGDT][l * 16 + g]);
            float ar, ai, cr, ci; cpow_exp(lr, li, dt, 1.f, ar, ai); ssm_cf(lr, li, dt, cr, ci);
            const float* br = Pp->in[I_BRE] + ((size_t)(l * 16 + g) * 64 + p) * 16; const float* bi = Pp->in[I_BIM] + ((size_t)(l * 16 + g) * 64 + p) * 16;
            f32x4 Br[4], Bi[4];
#pragma unroll
            for (int q = 0; q < 4; ++q) { const f32x4 b_r = *(const f32x4*)(br + 4 * q), b_i = *(const f32x4*)(bi + 4 * q); Br[q] = b_r * cr - b_i * ci; Bi[q] = b_i * cr + b_r * ci; }
            const size_t si = ((size_t)(l * 16 + b) * 16 + g) * 64 + p;
            float hr = Pp->in[I_SRE][si], hi = Pp->in[I_SIM][si];
            for (int t = 0; t < 32; ++t) {
                float bur = 0.f, bui = 0.f;
#pragma unroll
                for (int q = 0; q < 4; ++q)
#pragma unroll
                    for (int e = 0; e < 4; ++e) { const float uu = us[t * 16 + 4 * q + e]; bur += Br[q][e] * uu; bui += Bi[q][e] * uu; }
                const float nr = ar * hr - ai * hi + bur, ni = ar * hi + ai * hr + bui; hr = nr; hi = ni;
                hsr[t * 65 + p] = hr; hsi[t * 65 + p] = hi;
            }
            Pp->out[O_SRS + si] = hr; Pp->out[O_SIS + si] = hi;
        }
        __syncthreads();
        {
            const int t = C.tid >> 4, c = C.tid & 15;
            const float* cre = Pp->in[I_CRE] + ((size_t)(l * 16 + g) * 16 + c) * 64; const float* cim = Pp->in[I_CIM] + ((size_t)(l * 16 + g) * 16 + c) * 64;
            float y = 0.f;
            for (int p = 0; p < 64; ++p) y += cre[p] * hsr[t * 65 + p] - cim[p] * hsi[t * 65 + p];
            y += Pp->in[I_SD][l * 256 + g * 16 + c] * us[C.tid];
            Z[(size_t)(MP + b * 32 + t) * 256 + g * 16 + c] = f2bf(gelu_tanh(y));
        }
        __syncthreads();
    }
}


#define XB_TMO      128
#define XB_XCNT(j)  (256  + 64 * (j))
#define XB_XSUB(j)  (1280 + 64 * (j))
#define XB_XGEN(j)  (2304 + 64 * (j))
#define XB_TOP      3328
#define XB_TOPGEN   3392
#define XCD_BAR_WORDS 3456
#define XB_SPIN_CAP (1u << 18)
__device__ __forceinline__ unsigned xb_ld(unsigned* p)              { return __hip_atomic_load(p, __ATOMIC_RELAXED, __HIP_MEMORY_SCOPE_AGENT); }
__device__ __forceinline__ unsigned xb_add(unsigned* p, unsigned v) { return __hip_atomic_fetch_add(p, v, __ATOMIC_RELAXED, __HIP_MEMORY_SCOPE_AGENT); }
__device__ __forceinline__ unsigned xb_xcc_id() { return (unsigned)__builtin_amdgcn_s_getreg((3 << 11) | 20) & 0xFu; }
#define XB_SPIN(cond, bar) do { unsigned _sp = 0; while (cond) { __builtin_amdgcn_s_sleep(1); \
    if ((++_sp & 255u) == 0u) { if (xb_ld(&(bar)[XB_TMO])) break; if (_sp > XB_SPIN_CAP) { atomicAdd(&(bar)[XB_TMO], 1u); break; } } } } while (0)
struct XcdBarrier { unsigned* bar; unsigned x; volatile LAS unsigned* st; };
__device__ __forceinline__ void xcd_barrier_complete(unsigned* bar, unsigned x, unsigned& nloc, unsigned& nx) {
    const unsigned G = gridDim.x * gridDim.y * gridDim.z;
    unsigned sum, cnt, mine, sp = 0u;
    for (;;) {
        sum = 0u; cnt = 0u; mine = 0u;
#pragma unroll
        for (unsigned j = 0; j < 16; ++j) { const unsigned c = xb_ld(&bar[XB_XCNT(j)]); sum += c; cnt += (c > 0u) ? 1u : 0u; mine = (j == x) ? c : mine; }
        if (sum == G) break;
        __builtin_amdgcn_s_sleep(1);
        if ((++sp & 255u) == 0u) { if (xb_ld(&bar[XB_TMO])) break; if (sp > XB_SPIN_CAP) { atomicAdd(&bar[XB_TMO], 1u); break; } }
    }
    nloc = mine > 0u ? mine : 1u; nx = cnt > 0u ? cnt : 1u;
}
__device__ __forceinline__ void xcd_barrier(const XcdBarrier& b) {
    asm volatile("s_waitcnt vmcnt(0)" ::: "memory");
    __syncthreads();
    if (threadIdx.x == 0) {
        unsigned* bar = b.bar;
        __builtin_amdgcn_s_waitcnt(0);
        unsigned nloc = b.st[0], nx = b.st[1];
        if (nloc == 0u) { xcd_barrier_complete(bar, b.x, nloc, nx); b.st[0] = nloc; b.st[1] = nx; }
        const unsigned old = xb_add(&bar[XB_XSUB(b.x)], 1u);
        const unsigned gen = old / nloc;
        if (old + 1u == (gen + 1u) * nloc) {
            __builtin_amdgcn_fence(__ATOMIC_RELEASE, "agent");
            asm volatile("s_waitcnt vmcnt(0)" ::: "memory");
            const unsigned og = xb_add(&bar[XB_TOP], 1u);
            const unsigned tg = og / nx;
            if (og + 1u == (tg + 1u) * nx) xb_add(&bar[XB_TOPGEN], 1u);
            else XB_SPIN(xb_ld(&bar[XB_TOPGEN]) == tg, bar);
            __builtin_amdgcn_fence(__ATOMIC_ACQUIRE, "agent");
            xb_add(&bar[XB_XGEN(b.x)], 1u);
            asm volatile("s_waitcnt vmcnt(0)" ::: "memory");
        } else {
            XB_SPIN(xb_ld(&bar[XB_XGEN(b.x)]) == gen, bar);
            __builtin_amdgcn_fence(__ATOMIC_ACQUIRE, "agent");
            asm volatile("s_waitcnt vmcnt(0)" ::: "memory");
        }
    }
    __syncthreads();
}

enum { ST_PROJ = 0, ST_ATTN, ST_HLOC, ST_SCAN, ST_YSSM, ST_GLU, ST_OUT, ST_LN1, ST_FFIN, ST_FFOUT, ST_PER_LAYER };
constexpr int N_STEPS = 2 + NL * ST_PER_LAYER + 1;

__global__ void __launch_bounds__(512, 2) mega(Params P) {
    extern __shared__ __attribute__((aligned(16))) unsigned char lds_raw[];
    LAS unsigned char* lds = (LAS unsigned char*)lds_raw;
    const int step_lo = get_params()->lo, step_hi = get_params()->hi;
    volatile LAS unsigned* xst = (volatile LAS unsigned*)(lds + LDS_BYTES - 64);
    if (threadIdx.x == 0) { xst[0] = 0u; xst[1] = 0u; }
    __syncthreads();
    XcdBarrier xbar; xbar.bar = (unsigned*)(get_params()->ws + 4096); xbar.x = xb_xcc_id(); xbar.st = xst;
    if (step_hi - step_lo > 1 && threadIdx.x == 0) (void)xb_add(&xbar.bar[XB_XCNT(xbar.x)], 1u);
    for (int step = step_lo; step < step_hi; ++step) {
        bool sync_after = true;
        const CParams Pp = get_params();
        int tid_ = threadIdx.x, bid_ = blockIdx.x, G_ = gridDim.x; asm volatile("" : "+v"(tid_)); asm volatile("" : "+s"(bid_), "+s"(G_));
        Ctx C; C.tid = tid_; C.lane = tid_ & 63; C.wave = __builtin_amdgcn_readfirstlane(tid_ >> 6); C.G = G_; C.bid = bid_;
        C.gtid = bid_ * 512 + tid_; C.NT = G_ * 512; C.gw = bid_ * 8 + C.wave; C.NGW = G_ * 8;
        if (step == 0) { prologue_phase(C, lds); __syncthreads(); ssm_T_phase(C, 0, lds); }
        else if (step == 1) {
            ssm_fill_phase(C, 0);
            for (int item = C.gtid; item < NL * 2560; item += C.NT) {
                const int l = item / 2560, n = item % 2560; const float* src = (const float*)(Pp->ws + W_CSP) + ((size_t)l * 16 * 2560 + n) * 2;
                float cs = 0.f, bs = 0.f;
#pragma unroll
                for (int kc = 0; kc < 16; ++kc) { cs += src[(size_t)kc * 2560 * 2]; bs += src[(size_t)kc * 2560 * 2 + 1]; }
                float* dst = (float*)(Pp->ws + W_CS) + l * CS_L + n; dst[0] = cs; dst[2560] = bs;
            }
        }
        else if (step == N_STEPS - 1) { ln_phase(C, Pp->ws, Pp->in[I_LN2G] + (NL - 1) * 1024, Pp->in[I_LN2B] + (NL - 1) * 1024, Pp->out); }
        else {
            const int l = (step - 2) / ST_PER_LAYER, st = (step - 2) % ST_PER_LAYER;
            bool is_gemm = false; pg8::Gemm g; Epi E; E.l = l; E.mode = EM_PROJ; E.sub = 0;
            g.batch = 1; g.kshift = 0; g.ablk = 64; g.nM1 = 1 << 30; g.off2 = 0;
            switch (st) {
            case ST_PROJ: is_gemm = true; E.mode = EM_PROJ; g.A = (const bf16_t*)(Pp->ws + W_XV); g.Bt = (const bf16_t*)(Pp->ws + W_WIN) + (size_t)l * NPROJ * DM; g.M = MT; g.N = NPROJ; g.K = DM; g.lda = DM; g.ldb = DM; break;
            case ST_ATTN: attn_phase(C, l, lds); if (l + 1 < NL) { __syncthreads(); ssm_T_phase(C, l + 1, lds); } sync_after = false; break;
            case ST_HLOC: is_gemm = true; E.mode = EM_HLOC; g.A = (const bf16_t*)(Pp->ws + W_U2); g.Bt = (const bf16_t*)(Pp->ws + W_HM); g.M = 1024; g.N = 256; g.K = 256; g.lda = 1152; g.ldb = 1024; g.batch = 64; g.kshift = 2; break;
            case ST_SCAN: scan_phase(C, l, lds); break;
            case ST_YSSM: is_gemm = true; E.mode = EM_YSSM; g.A = (const bf16_t*)(Pp->ws + W_U2); g.Bt = (const bf16_t*)(Pp->ws + W_YK); g.M = 1024; g.N = 1024; g.K = 1152; g.lda = 1152; g.ldb = 1152; g.batch = 16; break;
            case ST_GLU: is_gemm = true; E.mode = EM_GLU; g.A = (const bf16_t*)(Pp->ws + W_Z); g.Bt = (const bf16_t*)(Pp->ws + W_WGLU) + (size_t)l * 65536; g.M = MT; g.N = 256; g.K = 256; g.lda = 256; g.ldb = 256; break;
            case ST_OUT: if (l + 1 < NL && C.bid >= 8 && C.G > 8) { Ctx C2 = C; C2.gtid = (C.bid - 8) * 512 + C.tid; C2.NT = (C.G - 8) * 512; ssm_fill_phase(C2, l + 1); }
                         else if (l + 1 < NL && C.G <= 8) ssm_fill_phase(C, l + 1);
                         is_gemm = true; E.mode = EM_RES; g.A = (const bf16_t*)(Pp->ws + W_MIX); g.Bt = (const bf16_t*)(Pp->ws + W_WOUT) + (size_t)l * DM * DM; g.M = MT; g.N = DM; g.K = DM; g.lda = DM; g.ldb = DM; break;
            case ST_LN1: ln_phase(C, Pp->ws, Pp->in[I_LN1G] + l * 1024, Pp->in[I_LN1B] + l * 1024, nullptr); break;
            case ST_FFIN: is_gemm = true; E.mode = EM_FFIN; g.A = (const bf16_t*)(Pp->ws + W_XV) - 2 * DM; g.Bt = (const bf16_t*)(Pp->ws + W_WFFI) + (size_t)l * DFF2 * DM; g.M = (NTP + NTS) * 256; g.N = DFF2; g.K = DM; g.lda = DM; g.ldb = DM; g.ablk = 62; g.nM1 = NTP; g.off2 = (unsigned)MP * DM * 2u; break;
            case ST_FFOUT: is_gemm = true; E.mode = EM_RES; E.sub = 1; g.A = (const bf16_t*)Pp->out; g.Bt = (const bf16_t*)(Pp->ws + W_WFFO) + (size_t)l * DM * DFF; g.M = MT; g.N = DM; g.K = DFF; g.lda = DFF; g.ldb = DFF; break;
            default: break;
            }
            if (is_gemm) { __syncthreads(); pg8::Order S; S.init(g.M, g.N, g.batch, C.G, (int)C.bid); S.rev = (st == ST_FFOUT || st == ST_OUT) ? 1 : 0; pg8::gemm_phase<Epi>(lds, g, S, E, C.tid); }
            if (st == ST_FFOUT && l + 1 < NL && C.G > 8 && C.bid >= 8) {
                Ctx C2 = C; C2.bid = C.bid - 8; C2.G = C.G - 8; C2.gtid = C2.bid * 512 + C.tid; C2.NT = C2.G * 512; C2.gw = C2.bid * 8 + C.wave; C2.NGW = C2.G * 8;
                convert_layer(C2, lds, l + 1);
            }
        }
        if (step + 1 < step_hi) {
            if (!sync_after) __syncthreads(); else if (step_hi == 0x7fffffff) cg::this_grid().sync(); else xcd_barrier(xbar);
        }
    }
}

extern "C" void kernel_launch(void* const* d_in, const int* in_sizes, int n_in, void* d_out, int out_size, void* d_ws, size_t ws_size, hipStream_t stream) {
    static int grid = 0;
    if (grid == 0) {
        if (n_in != 32 || (size_t)out_size != O_END || ws_size < W_END) { fprintf(stderr, "kernel_launch: unexpected sizes n_in=%d out=%d ws=%zu (need %zu)\n", n_in, out_size, ws_size, (size_t)W_END); grid = -1; return; }
        int dev = 0, cus = 0, per_cu = 0;
        hipGetDevice(&dev); hipDeviceGetAttribute(&cus, hipDeviceAttributeMultiprocessorCount, dev);
        hipFuncSetAttribute((const void*)mega, hipFuncAttributeMaxDynamicSharedMemorySize, LDS_BYTES);
        hipOccupancyMaxActiveBlocksPerMultiprocessor(&per_cu, (const void*)mega, 512, LDS_BYTES);
        if (per_cu < 1) { fprintf(stderr, "kernel_launch: occupancy query says %d blocks/CU\n", per_cu); per_cu = 1; }
        (void)hipGetLastError();
        grid = cus;
    }
    if (grid < 0) return;
    Params p{};
    for (int i = 0; i < 32; ++i) p.in[i] = (const float*)d_in[i];
    p.out = (float*)d_out; p.ws = (unsigned char*)d_ws;
#if SINGLE_LAUNCH
    hipMemsetAsync(d_ws, 0, 65536, stream);
    p.lo = 0; p.hi = N_STEPS;
    void* args[] = {&p};
    hipError_t e = hipLaunchCooperativeKernel((const void*)mega, dim3(grid), dim3(512), args, LDS_BYTES, stream);
    if (e != hipSuccess) fprintf(stderr, "cooperative launch failed: %s (grid %d)\n", hipGetErrorString(e), grid);
#else
#ifndef DBG_NSTEP
#define DBG_NSTEP N_STEPS
#endif
    for (int s = 0; s < DBG_NSTEP; ++s) {
        p.lo = s; p.hi = s + 1;
        hipLaunchKernelGGL(mega, dim3(grid), dim3(512), LDS_BYTES, stream, p);
    }
#ifdef DBG_DUMP
    hipMemcpyAsync(d_out, (unsigned char*)d_ws + DBG_DUMP, (size_t)500 * 1024 * 1024, hipMemcpyDeviceToDevice, stream);
#endif
#endif
}
```

```cpp
#include <hip/hip_runtime.h>
#include <hip/hip_cooperative_groups.h>
#include <cstdio>
#include <cstdint>
namespace cg = cooperative_groups;

#ifndef SINGLE_LAUNCH
#define SINGLE_LAUNCH 1
#endif

#define LAS __attribute__((address_space(3)))
typedef unsigned short bf16_t;
typedef short bf16x8 __attribute__((ext_vector_type(8)));
typedef float f32x4 __attribute__((ext_vector_type(4)));
typedef unsigned u32x4 __attribute__((ext_vector_type(4)));
typedef unsigned u32x2 __attribute__((ext_vector_type(2)));

constexpr int MP = 65536, MS = 512, MT = MP + MS;
constexpr int DM = 1024, NPROJ = 2560, DFF2 = 4096, DFF = 2048, NL = 4;
constexpr float ALPHA = 1.681792830507429f;
constexpr float LN_EPS = 1e-5f;
constexpr float LOG2E = 1.4426950408889634f;
constexpr int NCHK = 1032;

constexpr size_t O_Y = 0;
constexpr size_t O_KP = (size_t)MT * DM;
constexpr size_t O_VP = O_KP + (size_t)NL * 32 * 512 * 512;
constexpr size_t O_KS = O_VP + (size_t)NL * 32 * 512 * 512;
constexpr size_t O_VS = O_KS + (size_t)NL * 16 * 32 * 512;
constexpr size_t O_SRP = O_VS + (size_t)NL * 16 * 32 * 512;
constexpr size_t O_SIP = O_SRP + (size_t)NL * 32 * 16 * 64;
constexpr size_t O_SRS = O_SIP + (size_t)NL * 32 * 16 * 64;
constexpr size_t O_SIS = O_SRS + (size_t)NL * 16 * 16 * 64;
constexpr size_t O_SCP = O_SIS + (size_t)NL * 16 * 16 * 64;
constexpr size_t O_SCS = O_SCP + (size_t)NL * 32 * 2 * 256;
constexpr size_t O_FFP = O_SCS + (size_t)NL * 16 * 2 * 256;
constexpr size_t O_FFS = O_FFP + (size_t)NL * 32 * 2 * 4096;
constexpr size_t O_END = O_FFS + (size_t)NL * 16 * 2 * 4096;
static_assert(O_END == 138903552, "out size");

constexpr size_t W_WIN = 1u << 20;
constexpr size_t W_WOUT = W_WIN + (size_t)NL * NPROJ * DM * 2;
constexpr size_t W_WFFI = W_WOUT + (size_t)NL * DM * DM * 2;
constexpr size_t W_WFFO = W_WFFI + (size_t)NL * DFF2 * DM * 2;
constexpr size_t W_WGLU = W_WFFO + (size_t)NL * DM * DFF * 2;
constexpr size_t W_SSMT = W_WGLU + (size_t)NL * 256 * 256 * 2;
constexpr size_t W_YK = W_SSMT + (size_t)16 * 64 * 256 * 4;
constexpr size_t W_HM = W_YK + (size_t)16 * 1024 * 1152 * 2;
constexpr size_t W_HLOC = W_HM + (size_t)16 * 256 * 1024 * 2;
constexpr size_t W_XV = W_HLOC + (size_t)4 * 16 * 1024 * 128 * 4;
constexpr size_t W_KS = W_XV + (size_t)MT * DM * 2;
constexpr size_t W_VFS = W_KS + (size_t)NL * 128 * 544 * 64 * 2;
constexpr size_t W_US = W_VFS + (size_t)NL * 128 * 18 * 2048 * 2;
constexpr size_t W_CW = W_US + (size_t)MS * 256 * 2;
constexpr size_t W_STA = W_CW + (size_t)NL * 512 * 32 * 4;
constexpr size_t W_STB = W_STA + (size_t)MT * 32;
constexpr size_t W_CS = W_STB + (size_t)MT * 32;
constexpr int CS_L = 13312;
constexpr size_t W_ONE = W_CS + (size_t)NL * CS_L * 4;
constexpr size_t W_CSP = W_ONE + 8192;
constexpr size_t W_RA = W_CSP + (size_t)NL * 16 * 2560 * 8;
constexpr size_t W_QH = W_RA;
constexpr size_t W_KH = W_QH + (size_t)8 * MT * 64 * 2;
constexpr size_t W_VF = W_KH + (size_t)8 * MT * 64 * 2;
constexpr size_t W_U2 = W_VF + (size_t)8 * NCHK * 4096 * 2;
constexpr size_t W_G = W_U2 + (size_t)16 * 1024 * 1152 * 2;
constexpr size_t W_MIX = W_G + (size_t)MT * 768 * 2;
constexpr size_t W_Z = W_MIX + (size_t)MT * DM * 2;
constexpr size_t W_RA_END1 = W_Z + (size_t)MT * 256 * 2;
constexpr size_t W_END = W_RA_END1;
static_assert(W_END < (size_t)1000 * 1024 * 1024, "ws budget");

constexpr int LDS_RED = 131072;
constexpr int LDS_RS = LDS_RED + 8192;
constexpr int LDS_ST = LDS_RS + 2048;
constexpr int LDS_BYTES = 131072 + 8192 + 2048 + 16384 + 1024;

struct Params {
    const float* in[32];
    float* out;
    unsigned char* ws;
    int lo, hi;
};
typedef const Params __attribute__((address_space(4)))* CParams;
__device__ __forceinline__ CParams get_params() { CParams p = (CParams)__builtin_amdgcn_kernarg_segment_ptr(); asm volatile("" : "+s"(p)); return p; }
enum { I_XP = 0, I_XS, I_CK, I_CV, I_SRE, I_SIM, I_CSC, I_CFF, I_LNG, I_LNB, I_WIN, I_RELB, I_LAMRE, I_LAMIM, I_LOGDT,
       I_BRE, I_BIM, I_CRE, I_CIM, I_SD, I_WGLU, I_SCW, I_SCB, I_WOUT, I_LN1G, I_LN1B, I_WFFI, I_FCW, I_FCB, I_WFFO, I_LN2G, I_LN2B };

typedef float f32x2_t __attribute__((ext_vector_type(2))); typedef __bf16 bf16x2_t __attribute__((ext_vector_type(2)));
__device__ __forceinline__ unsigned cvt_pk_bf16(float lo, float hi) { f32x2_t v = {lo, hi}; bf16x2_t b = __builtin_convertvector(v, bf16x2_t); return __builtin_bit_cast(unsigned, b); }
__device__ __forceinline__ float bf_lo(unsigned w) { return __uint_as_float(w << 16); }
__device__ __forceinline__ float bf_hi(unsigned w) { return __uint_as_float(w & 0xffff0000u); }
__device__ __forceinline__ float bf1(bf16_t b) { return __uint_as_float(((unsigned)b) << 16); }
__device__ __forceinline__ bf16_t f2bf(float f) { return (bf16_t)(cvt_pk_bf16(f, 0.f) & 0xffffu); }
__device__ __forceinline__ u32x4 pack8(const f32x4 a, const f32x4 b) { u32x4 w; w.x = cvt_pk_bf16(a[0], a[1]); w.y = cvt_pk_bf16(a[2], a[3]); w.z = cvt_pk_bf16(b[0], b[1]); w.w = cvt_pk_bf16(b[2], b[3]); return w; }
__device__ __forceinline__ void unpack8(const u32x4 w, f32x4& a, f32x4& b) { a = (f32x4){bf_lo(w.x), bf_hi(w.x), bf_lo(w.y), bf_hi(w.y)}; b = (f32x4){bf_lo(w.z), bf_hi(w.z), bf_lo(w.w), bf_hi(w.w)}; }
__device__ __forceinline__ float fexp2(float x) { return __builtin_amdgcn_exp2f(x); }
__device__ __forceinline__ float frcp(float x) { return __builtin_amdgcn_rcpf(x); }
__device__ __forceinline__ float sigmoidf_(float a) { return frcp(1.f + fexp2(-LOG2E * a)); }
__device__ __forceinline__ float gelu_tanh(float y) { const float t = y + 0.044715f * y * y * y; return y * frcp(1.f + fexp2(-2.f * 0.7978845608028654f * LOG2E * t)); }
template <int CTRL> __device__ __forceinline__ float dpp_mov(float v) { return __int_as_float(__builtin_amdgcn_update_dpp(0, __float_as_int(v), CTRL, 0xF, 0xF, true)); }
__device__ __forceinline__ float xsum16(float v) { auto r = __builtin_amdgcn_permlane16_swap(__float_as_uint(v), __float_as_uint(v), false, false); return __uint_as_float(r[0]) + __uint_as_float(r[1]); }
__device__ __forceinline__ float xsum32(float v) { auto r = __builtin_amdgcn_permlane32_swap(__float_as_uint(v), __float_as_uint(v), false, false); return __uint_as_float(r[0]) + __uint_as_float(r[1]); }
__device__ __forceinline__ float xmax16(float v) { auto r = __builtin_amdgcn_permlane16_swap(__float_as_uint(v), __float_as_uint(v), false, false); return fmaxf(__uint_as_float(r[0]), __uint_as_float(r[1])); }
__device__ __forceinline__ float xmax32(float v) { auto r = __builtin_amdgcn_permlane32_swap(__float_as_uint(v), __float_as_uint(v), false, false); return fmaxf(__uint_as_float(r[0]), __uint_as_float(r[1])); }
__device__ __forceinline__ float wave_sum(float v) {
    v += dpp_mov<0xB1>(v); v += dpp_mov<0x4E>(v); v += dpp_mov<0x141>(v); v += dpp_mov<0x140>(v);
    return xsum32(xsum16(v));
}
__device__ __forceinline__ void cpow_exp(float lr, float li, float dt, float tau, float& er, float& ei) {
    const float mag = __expf(lr * dt * tau); const float th = (li * dt) * tau;
    const float k = rintf(th * 0.15915494309189535f);
    float r = fmaf(-k, 6.28318548202514648f, th); r = fmaf(-k, -1.7484555e-7f, r);
    const float rev = r * 0.15915494309189535f;
    const float s = __builtin_amdgcn_sinf(rev), c = __builtin_amdgcn_cosf(rev);
    er = mag * c; ei = mag * s;
}
__device__ __forceinline__ void ssm_cf(float lr, float li, float dt, float& cr, float& ci) {
    float er, ei; cpow_exp(lr, li, dt, 1.f, er, ei);
    const float nr = er - 1.f, ni = ei; const float den = frcp(lr * lr + li * li) ;
    cr = (nr * lr + ni * li) * den; ci = (ni * lr - nr * li) * den;
}

namespace pg8 {
constexpr int BM = 256, BK = 64, HALF = 128, HTB = HALF * BK * 2, NXCD = 8, WGM = 8;
__device__ __forceinline__ int lds_byte(int r, int c) { const int st = (r >> 4) * 2 + (c >> 5), rr = r & 15, cc = c & 31, ob = rr * 64 + cc * 2; return st * 1024 + (ob ^ (((ob >> 9) & 1) << 5)); }
__device__ __forceinline__ void stage_rc(int b, int& R, int& C) { const int st = b / 1024, sb = b % 1024, swz = sb ^ (((sb >> 9) & 1) << 5); R = (st >> 1) * 16 + swz / 64; C = (st & 1) * 32 + (swz % 64) / 2; }
__device__ __forceinline__ int perm32(int rho) { const int n = rho >> 4, i = rho & 15; return 8 * (i >> 2) + 4 * n + (i & 3); }

struct Unit { int pm, pn, bz; };
struct Gemm { const bf16_t* A; const bf16_t* Bt; int M, N, K, lda, ldb, batch; int ablk, nM1; unsigned off2; int kshift; };

struct Order {
    int nM, nN, nwg, total, G, c, rev;
    __device__ __forceinline__ void init(int M, int N, int batch, int G_, int c_) { nM = M / BM; nN = N / BM; nwg = nM * nN; total = nwg * batch; G = G_; c = c_; rev = 0; }
    __device__ __forceinline__ bool next(int i, Unit& u) const {
        const long L = (long)i * G + c; if (L >= total) return false;
        const int bz = (int)(L / nwg); int wgid = (int)(L % nwg);
        { const int q = nwg / NXCD, r = nwg % NXCD, xcd = wgid % NXCD; int off = wgid / NXCD; if (rev) off = (q + (xcd < r ? 1 : 0)) - 1 - off; wgid = (xcd < r ? xcd * (q + 1) : r * (q + 1) + (xcd - r) * q) + off; }
        const int nig = WGM * nN, gid = wgid / nig, fm = gid * WGM, gsz = (nM - fm) < WGM ? (nM - fm) : WGM;
        u.pm = fm + ((wgid % nig) % gsz); u.pn = (wgid % nig) / gsz; u.bz = bz; return true;
    }
};

template <class Epi>
__device__ __forceinline__ void gemm_phase(LAS unsigned char* lds, const Gemm g, const Order& S, const Epi& E, const int tid) {
    const int wid = __builtin_amdgcn_readfirstlane(tid >> 6), lane = tid & 63, wr = wid >> 2, wc = wid & 3, fr = lane & 15, fq = lane >> 4;
    const int nt = g.K / BK;
    unsigned voffA[2], voffB[2];
#pragma unroll
    for (int i = 0; i < 2; ++i) { int R, C; stage_rc(tid * 16 + i * 8192, R, C); const int Rb = (R & ~31) + perm32(R & 31);
        voffA[i] = (unsigned)((g.ablk * (R >> 6) + (R & 63)) * g.lda + C) * 2u; voffB[i] = (unsigned)(Rb * g.ldb + C) * 2u; }
    const size_t kstep = (size_t)(BK * 2);
    const unsigned hstepA = 2u * g.ablk * g.lda * 2u, hstepB = (unsigned)HALF * g.ldb * 2u;
    const unsigned tstepA = 2 * hstepA, tstepB = 2 * hstepB;
    const int nMb = g.M / BM, nNb = g.N / BM;
    const unsigned ldsw = (unsigned)wid * 1024u;
    const int aoff = lds_byte(wr * 64 + fr, fq * 8), boff = lds_byte(wc * 32 + fr, fq * 8);
#define PG8_SA(b, h) (((b) * 2 + (h)) * HTB)
#define PG8_SB(b, h) ((4 + (b) * 2 + (h)) * HTB)
#define PG8_STAGE(bufoff, gbase, voff) do { _Pragma("unroll") for (int _i = 0; _i < 2; ++_i) \
        __builtin_amdgcn_global_load_lds((const unsigned*)((const char*)(gbase) + (voff)[_i]), (LAS unsigned*)(lds + (bufoff) + ldsw + _i * 8192), 16, 0, 0); } while (0)
#define PG8_LDA(dst, b, h) do { _Pragma("unroll") for (int m = 0; m < 4; ++m) _Pragma("unroll") for (int k = 0; k < 2; ++k) dst[m][k] = *(const LAS bf16x8*)(lds + PG8_SA(b, h) + aoff + m * 2048 + k * 1024); } while (0)
#define PG8_LDB(dst, b, h) do { _Pragma("unroll") for (int n = 0; n < 2; ++n) _Pragma("unroll") for (int k = 0; k < 2; ++k) dst[n][k] = *(const LAS bf16x8*)(lds + PG8_SB(b, h) + boff + n * 2048 + k * 1024); } while (0)
#define PG8_MMA(ai, bj, At, Bt) do { __builtin_amdgcn_s_setprio(1); _Pragma("unroll") for (int m = 0; m < 4; ++m) _Pragma("unroll") for (int n = 0; n < 2; ++n) _Pragma("unroll") for (int k = 0; k < 2; ++k) \
        acc[ai][bj][m][n] = __builtin_amdgcn_mfma_f32_16x16x32_bf16(Bt[n][k], At[m][k], acc[ai][bj][m][n], 0, 0, 0); __builtin_amdgcn_s_setprio(0); } while (0)
#define PG8_WAIT_V(n) asm volatile("s_waitcnt vmcnt(" #n ")" ::: "memory")
#define PG8_WAIT_L(n) asm volatile("s_waitcnt lgkmcnt(" #n ")" ::: "memory")
#define PG8_BAR __builtin_amdgcn_s_barrier()
#define PG8_SCHED __builtin_amdgcn_sched_barrier(0)
    Unit cur, nxt; int ui = 0;
    if (!S.next(0, cur)) return;
    f32x4 acc[2][2][4][2];
#pragma unroll
    for (int a = 0; a < 2; ++a)
#pragma unroll
        for (int b = 0; b < 2; ++b)
#pragma unroll
            for (int m = 0; m < 4; ++m)
#pragma unroll
                for (int n = 0; n < 2; ++n) acc[a][b][m][n] = (f32x4){0.f, 0.f, 0.f, 0.f};
    bf16x8 At[4][2], B0[2][2], B1[2][2];
#define PG8_KOFF(u_) ((unsigned)(((u_).bz & ((1 << g.kshift) - 1)) * g.K) * 2u)
#define PG8_ABASE(u_) ((const char*)g.A + PG8_KOFF(u_) + ((u_).pm < g.nM1 ? (size_t)(((u_).bz >> g.kshift) * nMb + (u_).pm) * tstepA : (size_t)g.off2 + (size_t)((u_).pm - g.nM1) * tstepA))
#define PG8_BBASE(u_) ((const char*)g.Bt + PG8_KOFF(u_) + (size_t)(((u_).bz >> g.kshift) * nNb + (u_).pn) * tstepB)
    E.prefetch(lds, cur, 0, tid);
    const char* cA = PG8_ABASE(cur);
    const char* cB = PG8_BBASE(cur);
    PG8_STAGE(PG8_SB(0, 0), cB, voffB); PG8_STAGE(PG8_SB(0, 1), cB + hstepB, voffB); PG8_STAGE(PG8_SA(0, 0), cA, voffA); PG8_STAGE(PG8_SA(0, 1), cA + hstepA, voffA);
    if (wr == 1) PG8_BAR;
    PG8_WAIT_V(2); PG8_BAR;
    PG8_STAGE(PG8_SB(1, 0), cB + kstep, voffB); PG8_STAGE(PG8_SA(1, 0), cA + kstep, voffA); PG8_STAGE(PG8_SB(1, 1), cB + hstepB + kstep, voffB);
    PG8_WAIT_V(6); PG8_BAR;
    for (;;) {
        const bool has_next = S.next(ui + 1, nxt);
        const char* nA = has_next ? PG8_ABASE(nxt) : cA;
        const char* nB = has_next ? PG8_BBASE(nxt) : cB;
        for (int t = 0; t < nt; t += 2) {
            const bool last = (t == nt - 2);
            const char* a1 = cA + (size_t)(t + 1) * kstep;
            const char* a2 = last ? nA : cA + (size_t)(t + 2) * kstep; const char* b2 = last ? nB : cB + (size_t)(t + 2) * kstep;
            const char* a3 = a2 + kstep; const char* b3 = b2 + kstep;
            PG8_LDB(B0, 0, 0); PG8_LDB(B1, 0, 1); PG8_SCHED; PG8_LDA(At, 0, 0); PG8_STAGE(PG8_SA(1, 1), a1 + hstepA, voffA);
            PG8_WAIT_V(8); PG8_WAIT_L(0); PG8_BAR; PG8_MMA(0, 0, At, B0); PG8_MMA(0, 1, At, B1); PG8_BAR; PG8_SCHED;
            PG8_LDA(At, 0, 1); PG8_STAGE(PG8_SB(0, 0), b2, voffB); PG8_STAGE(PG8_SB(0, 1), b2 + hstepB, voffB); PG8_STAGE(PG8_SA(0, 0), a2, voffA);
            PG8_WAIT_V(8); PG8_WAIT_L(0); PG8_BAR; PG8_MMA(1, 0, At, B0); PG8_MMA(1, 1, At, B1); PG8_BAR; PG8_SCHED;
            PG8_LDB(B0, 1, 0); PG8_LDB(B1, 1, 1); PG8_SCHED; PG8_LDA(At, 1, 0); PG8_STAGE(PG8_SA(0, 1), a2 + hstepA, voffA);
            PG8_WAIT_V(8); PG8_WAIT_L(0); PG8_BAR; PG8_MMA(0, 0, At, B0); PG8_MMA(0, 1, At, B1); PG8_BAR; PG8_SCHED;
            PG8_LDA(At, 1, 1); PG8_STAGE(PG8_SB(1, 0), b3, voffB); PG8_STAGE(PG8_SB(1, 1), b3 + hstepB, voffB); PG8_STAGE(PG8_SA(1, 0), a3, voffA);
            PG8_WAIT_V(8); PG8_WAIT_L(0); PG8_BAR; PG8_MMA(1, 0, At, B0); PG8_MMA(1, 1, At, B1); PG8_BAR; PG8_SCHED;
        }
        if (wr == 0) PG8_BAR;
        { int t2 = threadIdx.x; asm volatile("" : "+v"(t2));
          const int w2 = __builtin_amdgcn_readfirstlane(t2 >> 6), l2 = t2 & 63; E(acc, cur, w2 >> 2, w2 & 3, l2 & 15, l2 >> 4, ui & 1); }
        if (!has_next) break;
#pragma unroll
        for (int a = 0; a < 2; ++a)
#pragma unroll
            for (int b = 0; b < 2; ++b)
#pragma unroll
                for (int m = 0; m < 4; ++m)
#pragma unroll
                    for (int n = 0; n < 2; ++n) acc[a][b][m][n] = (f32x4){0.f, 0.f, 0.f, 0.f};
        cur = nxt; cA = nA; cB = nB; ++ui;
        E.prefetch(lds, cur, ui & 1, tid);
        if (wr == 1) PG8_BAR;
    }
    PG8_WAIT_V(0);
    PG8_BAR;
#undef PG8_ABASE
#undef PG8_KOFF
#undef PG8_BBASE
#undef PG8_SA
#undef PG8_SB
#undef PG8_STAGE
#undef PG8_LDA
#undef PG8_LDB
#undef PG8_MMA
#undef PG8_WAIT_V
#undef PG8_WAIT_L
#undef PG8_BAR
#undef PG8_SCHED
}
}

enum { EM_PROJ = 0, EM_HLOC, EM_YSSM, EM_GLU, EM_RES, EM_FFIN };
constexpr int NTP = 265, NTS = 3;
template <int CTRL> __device__ __forceinline__ float dppf(float old_, float src) { return __int_as_float(__builtin_amdgcn_update_dpp(__float_as_int(old_), __float_as_int(src), CTRL, 0xF, 0xF, false)); }
__device__ __forceinline__ float shift1(float cur, float prev) { return dppf<0x111>(dppf<0x121>(0.f, prev), cur); }
__device__ __forceinline__ float shift2(float cur, float prev) { return dppf<0x112>(dppf<0x122>(0.f, prev), cur); }
#define GST16(base, boff, val) (*(u32x4*)((unsigned char*)(base) + (unsigned)(boff)) = (val))
#define GSTF4(base, boff, val) (*(f32x4*)((unsigned char*)(base) + (unsigned)(boff)) = (val))
#define GST2(base, boff, val) (*(bf16_t*)((unsigned char*)(base) + (unsigned)(boff)) = (val))
#define GLD16(base, boff) (*(const u32x4*)((const unsigned char*)(base) + (unsigned)(boff)))
#define EPI_FENCE() asm volatile("" ::: "memory")
#define ROWSTAT(stb, row, mean_, rstd_) do { const f32x4 p0_ = *(const f32x4*)((stb) + (unsigned)(row) * 32u), p1_ = *(const f32x4*)((stb) + (unsigned)(row) * 32u + 16u); \
    mean_ = ((p0_[0] + p0_[2]) + (p1_[0] + p1_[2])) * (1.f / 1024.f); const float ex2_ = ((p0_[1] + p0_[3]) + (p1_[1] + p1_[3])) * (1.f / 1024.f); \
    rstd_ = __builtin_amdgcn_rsqf(ex2_ - mean_ * mean_ + LN_EPS); } while (0)
#define EPI_ROWSTATS_TO_LDS(stb) do { int t3_ = threadIdx.x; asm volatile("" : "+v"(t3_)); \
    if (t3_ < 256) { float mn_, rs_; ROWSTAT(stb, u.pm * 256 + t3_, mn_, rs_); LAS float* rsl_ = (LAS float*)(unsigned)LDS_RS; rsl_[2 * t3_] = mn_; rsl_[2 * t3_ + 1] = rs_; } \
    asm volatile("s_waitcnt lgkmcnt(0)" ::: "memory"); __builtin_amdgcn_s_barrier(); asm volatile("" ::: "memory"); } while (0)
#define EPI_RS(ai, m) (((const LAS float*)(unsigned)LDS_RS) + 2 * ((ai) * 128 + wr * 64 + (m) * 16 + fr_))
#define EPI_RSP(ai, m, mean_, rstd_) do { const LAS f32x4* pp_ = (const LAS f32x4*)(unsigned)(LDS_ST + par * 8192 + ((ai) * 128 + wr * 64 + (m) * 16 + fr_) * 32); const f32x4 p0_ = pp_[0], p1_ = pp_[1]; \
    mean_ = ((p0_[0] + p0_[2]) + (p1_[0] + p1_[2])) * (1.f / 1024.f); const float ex2_ = ((p0_[1] + p0_[3]) + (p1_[1] + p1_[3])) * (1.f / 1024.f); \
    rstd_ = __builtin_amdgcn_rsqf(ex2_ - mean_ * mean_ + LN_EPS); } while (0)
#define LN_CORRECT(cs_, bs_, colbase_) do { \
    _Pragma("unroll") for (int bj = 0; bj < 2; ++bj) _Pragma("unroll") for (int n = 0; n < 2; ++n) { const unsigned c4_ = (colbase_) + 128 * bj + 4 * n; \
        const f32x4 cc_ = *(const f32x4*)((cs_) + c4_), bb_ = *(const f32x4*)((bs_) + c4_); \
        _Pragma("unroll") for (int ai = 0; ai < 2; ++ai) _Pragma("unroll") for (int m = 0; m < 4; ++m) { const LAS float* rp_ = EPI_RS(ai, m); const float mn_ = rp_[0], rs_ = rp_[1]; \
            acc[ai][bj][m][n] = (acc[ai][bj][m][n] - cc_ * mn_) * rs_ + bb_; } } } while (0)
struct Epi {
    int mode, l;
    int sub;
    __device__ __forceinline__ void prefetch(LAS unsigned char* lds, const pg8::Unit& u, int par, int tid) const {
        const int wv = __builtin_amdgcn_readfirstlane(tid >> 6), ln = tid & 63;
        if (mode == EM_FFIN) {
            if (wv < 4) { const CParams Pf = get_params();
                __builtin_amdgcn_global_load_lds((const unsigned*)(Pf->ws + W_CW + (unsigned)((l * 512 + 32 * u.pn) * 128 + wv * 1024 + ln * 16)), (LAS unsigned*)(lds + LDS_RED + par * 4096 + wv * 1024), 16, 0, 0); }
        } else if (mode == EM_PROJ || (mode == EM_RES && sub == 0)) {
            const CParams Pf = get_params();
            __builtin_amdgcn_global_load_lds((const unsigned*)(Pf->ws + W_STA + (unsigned)(u.pm * 8192 + wv * 1024 + ln * 16)), (LAS unsigned*)(lds + LDS_ST + par * 8192 + wv * 1024), 16, 0, 0);
        }
    }
    __device__ __forceinline__ void operator()(f32x4 (&acc)[2][2][4][2], const pg8::Unit& u, int wr, int wc, int fr, int fq, int par) const {
#define EPI_COORDS() const CParams Pq = get_params(); float* const out = Pq->out; unsigned char* const ws = Pq->ws; (void)out; (void)ws; int fr_ = fr, fq_ = fq; asm volatile("" : "+v"(fr_), "+v"(fq_)); const unsigned rowb = (unsigned)(u.pm * 256 + wr * 64 + fr_); const unsigned colw = (unsigned)(wc * 32 + 8 * fq_); (void)rowb; (void)colw
        if (mode == EM_PROJ) {
            EPI_COORDS();
            const int pn = u.pn;
            {
                const float* cs = (const float*)(ws + W_CS) + l * CS_L;
                f32x4 cc_[2][2], bb_[2][2];
#pragma unroll
                for (int bj = 0; bj < 2; ++bj)
#pragma unroll
                    for (int n = 0; n < 2; ++n) { const unsigned c4_ = 256 * pn + colw + 128 * bj + 4 * n; cc_[bj][n] = *(const f32x4*)(cs + c4_); bb_[bj][n] = *(const f32x4*)(cs + 2560 + c4_); }
#pragma unroll
                for (int ai = 0; ai < 2; ++ai)
#pragma unroll
                    for (int m = 0; m < 4; ++m) { float mn_, rs_; EPI_RSP(ai, m, mn_, rs_);
#pragma unroll
                        for (int bj = 0; bj < 2; ++bj)
#pragma unroll
                            for (int n = 0; n < 2; ++n) acc[ai][bj][m][n] = (acc[ai][bj][m][n] - cc_[bj][n] * mn_) * rs_ + bb_[bj][n]; }
            }
            if (pn < 4) {
                const bool isk = pn >= 2; const unsigned pq = pn & 1;
                unsigned char* dst = ws + (isk ? W_KH : W_QH);
                const float sc = isk ? 1.f : 0.125f * LOG2E;
                const bool smp = u.pm >= 256; const bool tail = (u.pm & 7) >= 6;
                const unsigned d0 = 32 * (wc & 1) + 8 * fq_;
#pragma unroll
                for (int bj = 0; bj < 2; ++bj) {
                    const unsigned h = 4 * pq + 2 * bj + (wc >> 1);
                    const unsigned colk = 256 * pq + 128 * bj + colw;
#pragma unroll
                    for (int ai = 0; ai < 2; ++ai)
#pragma unroll
                        for (int m = 0; m < 4; ++m) {
                            const unsigned row = rowb + ai * 128 + m * 16;
                            const f32x4 v0 = acc[ai][bj][m][0], v1 = acc[ai][bj][m][1];
                            GST16(dst, ((h * MT + row) * 64 + d0) * 2, pack8(v0 * sc, v1 * sc));
                            if (isk) {
                                if (!smp) {
                                    if (tail) { const unsigned s = row & 2047, b = row >> 11; const unsigned o = (((l * 32 + b) * 512 + (s - 1536)) * 512 + colk) * 4;
                                        GSTF4(out + O_KP, o, v0); GSTF4(out + O_KP, o + 16, v1); }
                                } else {
                                    const unsigned ms = row - MP; const unsigned o = ((l * 512 + ms) * 512 + colk) * 4;
                                    GSTF4(out + O_KS, o, v0); GSTF4(out + O_KS, o + 16, v1);
                                    GST16(ws + W_KS, (((l * 128 + (ms >> 5) * 8 + h) * 544 + 512 + (ms & 31)) * 64 + d0) * 2, pack8(v0, v1));
                                }
                            }
                            EPI_FENCE();
                        }
                }
            } else if (pn < 6) {
                const unsigned pq = pn - 4;
                const bool smp = u.pm >= 256; const bool tail = (u.pm & 7) >= 6;
                const unsigned db = 2 * (wc & 1) + (fq_ >> 1), fqv = fr_ >> 2;
#pragma unroll
                for (int bj = 0; bj < 2; ++bj) {
                    const unsigned h = 4 * pq + 2 * bj + (wc >> 1);
                    const unsigned colk = 256 * pq + 128 * bj + colw;
#pragma unroll
                    for (int ai = 0; ai < 2; ++ai)
#pragma unroll
                        for (int m = 0; m < 4; ++m) {
                            const unsigned row = rowb + ai * 128 + m * 16;
                            const unsigned gc = 4 * u.pm + 2 * ai + wr, st = m >> 1, ii = (fr_ & 3) + 4 * (m & 1);
                            const f32x4 v0 = acc[ai][bj][m][0], v1 = acc[ai][bj][m][1];
                            const unsigned pb = ((((((h * NCHK + gc) * 2 + st) * 4 + db) * 64 + fqv * 16 + 8 * (fq_ & 1)) * 8) + ii) * 2;
#pragma unroll
                            for (int e = 0; e < 4; ++e) { GST2(ws + W_VF, pb + e * 16, f2bf(v0[e])); GST2(ws + W_VF, pb + (4 + e) * 16, f2bf(v1[e])); }
                            if (!smp) {
                                if (tail) { const unsigned s = row & 2047, b = row >> 11; const unsigned o = (((l * 32 + b) * 512 + (s - 1536)) * 512 + colk) * 4;
                                    GSTF4(out + O_VP, o, v0); GSTF4(out + O_VP, o + 16, v1); }
                            } else {
                                const unsigned ms = row - MP, t = ms & 31; const unsigned o = ((l * 512 + ms) * 512 + colk) * 4;
                                GSTF4(out + O_VS, o, v0); GSTF4(out + O_VS, o + 16, v1);
                                const unsigned i2 = (t & 3) + 4 * (t >> 4), fq2 = (t & 15) >> 2;
                                const unsigned ps = ((((((l * 128 + (ms >> 5) * 8 + h) * 18 + 16) * 4 + db) * 64 + fq2 * 16 + 8 * (fq_ & 1)) * 8) + i2) * 2;
#pragma unroll
                                for (int e = 0; e < 4; ++e) { GST2(ws + W_VFS, ps + e * 16, f2bf(v0[e])); GST2(ws + W_VFS, ps + (4 + e) * 16, f2bf(v1[e])); }
                            }
                            EPI_FENCE();
                        }
                }
            } else if (pn == 6) {
                const bool smp = u.pm >= 256;
#pragma unroll
                for (int bj = 0; bj < 2; ++bj) {
                    const unsigned col = 128 * bj + colw, g = col >> 4, ch0 = col & 15;
#pragma unroll
                    for (int ai = 0; ai < 2; ++ai)
#pragma unroll
                        for (int m = 0; m < 4; ++m) {
                            const unsigned row = rowb + ai * 128 + m * 16;
                            const u32x4 w = pack8(acc[ai][bj][m][0], acc[ai][bj][m][1]);
                            if (!smp) GST16(ws + W_U2, ((g * 1024 + (row >> 6)) * 1152 + (row & 63) * 16 + ch0) * 2, w);
                            else GST16(ws + W_US, ((row - MP) * 256 + col) * 2, w);
                            EPI_FENCE();
                        }
                }
            } else {
#pragma unroll
                for (int bj = 0; bj < 2; ++bj) {
                    const unsigned col = (pn - 7) * 256 + 128 * bj + colw;
#pragma unroll
                    for (int ai = 0; ai < 2; ++ai)
#pragma unroll
                        for (int m = 0; m < 4; ++m) {
                            const unsigned row = rowb + ai * 128 + m * 16;
                            GST16(ws + W_G, (row * 768 + col) * 2, pack8(acc[ai][bj][m][0], acc[ai][bj][m][1]));
                            EPI_FENCE();
                        }
                }
            }
        } else if (mode == EM_HLOC) {
            EPI_COORDS();
#pragma unroll
            for (int ai = 0; ai < 2; ++ai)
#pragma unroll
                for (int m = 0; m < 4; ++m) {
                    const unsigned row = rowb + ai * 128 + m * 16;
                    const unsigned o = (((((unsigned)u.bz & 3u) * 16u + ((unsigned)u.bz >> 2)) * 1024 + row) * 128 + colw) * 4;
                    GSTF4(ws + W_HLOC, o, acc[ai][0][m][0]); GSTF4(ws + W_HLOC, o + 16, acc[ai][0][m][1]);
                }
        } else if (mode == EM_YSSM) {
            EPI_COORDS();
            const unsigned g = u.bz;
            const float* dskip = Pq->in[I_SD] + l * 256;
#define Y_OFF(p_, q_, m_) (((g * 1024 + rowb + (p_) * 128 + (m_) * 16) * 1152 + 256 * u.pn + 128 * (q_) + colw) * 2)
            u32x4 buf[2][4];
#pragma unroll
            for (int m = 0; m < 4; ++m) buf[0][m] = GLD16(ws + W_U2, Y_OFF(0, 0, m));
#pragma unroll
            for (int bt = 0; bt < 4; ++bt) {
                const int bj = bt >> 1, ai = bt & 1;
                const unsigned col = 256 * u.pn + 128 * bj + colw, t = col >> 4, ch0 = col & 15;
                const f32x4 d0 = *(const f32x4*)(dskip + g * 16 + ch0), d1 = *(const f32x4*)(dskip + g * 16 + ch0 + 4);
                if (bt < 3) {
#pragma unroll
                    for (int m = 0; m < 4; ++m) buf[(bt + 1) & 1][m] = GLD16(ws + W_U2, Y_OFF((bt + 1) & 1, (bt + 1) >> 1, m));
                }
                EPI_FENCE();
#pragma unroll
                for (int m = 0; m < 4; ++m) {
                    const unsigned row = rowb + ai * 128 + m * 16;
                    f32x4 u0, u1; unpack8(buf[bt & 1][m], u0, u1);
                    f32x4 y0 = acc[ai][bj][m][0] + d0 * u0, y1 = acc[ai][bj][m][1] + d1 * u1;
#pragma unroll
                    for (int e = 0; e < 4; ++e) { y0[e] = gelu_tanh(y0[e]); y1[e] = gelu_tanh(y1[e]); }
                    GST16(ws + W_Z, ((row * 64 + t) * 256 + g * 16 + ch0) * 2, pack8(y0, y1));
                }
                EPI_FENCE();
            }
#undef Y_OFF
        } else if (mode == EM_GLU) {
            EPI_COORDS();
#define Z_OFF(p_, q_, m_) (((rowb + (p_) * 128 + (m_) * 16) * 256 + 128 * (q_) + colw) * 2)
            u32x4 buf[2][4];
#pragma unroll
            for (int m = 0; m < 4; ++m) buf[0][m] = GLD16(ws + W_Z, Z_OFF(0, 0, m));
#pragma unroll
            for (int bt = 0; bt < 4; ++bt) {
                const int bj = bt >> 1, ai = bt & 1;
                if (bt < 3) {
#pragma unroll
                    for (int m = 0; m < 4; ++m) buf[(bt + 1) & 1][m] = GLD16(ws + W_Z, Z_OFF((bt + 1) & 1, (bt + 1) >> 1, m));
                }
                EPI_FENCE();
#pragma unroll
                for (int m = 0; m < 4; ++m) {
                    const unsigned row = rowb + ai * 128 + m * 16;
                    f32x4 z0, z1; unpack8(buf[bt & 1][m], z0, z1);
                    f32x4 a0 = acc[ai][bj][m][0], a1 = acc[ai][bj][m][1];
#pragma unroll
                    for (int e = 0; e < 4; ++e) { a0[e] = z0[e] * sigmoidf_(a0[e]); a1[e] = z1[e] * sigmoidf_(a1[e]); }
                    GST16(ws + W_MIX, (row * 1024 + 512 + 128 * bj + colw) * 2, pack8(a0, a1));
                }
                EPI_FENCE();
            }
#undef Z_OFF
        } else if (mode == EM_RES) {
            EPI_COORDS();
#define RES_OFF(p_, q_, m_) (((rowb + (p_) * 128 + (m_) * 16) * 1024 + 256 * u.pn + 128 * (q_) + colw) * 2)
            if (sub == 0) {
                const float* gp = l ? Pq->in[I_LN2G] + (l - 1) * 1024 : (const float*)(ws + W_ONE);
                const float* bp = l ? Pq->in[I_LN2B] + (l - 1) * 1024 : (const float*)(ws + W_ONE) + 1024;
                u32x4 buf[2][4];
#pragma unroll
                for (int m = 0; m < 4; ++m) buf[0][m] = GLD16(ws + W_XV, RES_OFF(0, 0, m));
#pragma unroll
                for (int bt = 0; bt < 4; ++bt) {
                    const int bj = bt >> 1, ai = bt & 1;
                    const unsigned col = 256 * u.pn + 128 * bj + colw;
                    const f32x4 g0 = *(const f32x4*)(gp + col), g1 = *(const f32x4*)(gp + col + 4), b0 = *(const f32x4*)(bp + col), b1 = *(const f32x4*)(bp + col + 4);
                    if (bt < 3) {
#pragma unroll
                        for (int m = 0; m < 4; ++m) buf[(bt + 1) & 1][m] = GLD16(ws + W_XV, RES_OFF((bt + 1) & 1, (bt + 1) >> 1, m));
                    }
                    EPI_FENCE();
#pragma unroll
                    for (int m = 0; m < 4; ++m) {
                        float mn, rs; EPI_RSP(ai, m, mn, rs);
                        f32x4 x0, x1; unpack8(buf[bt & 1][m], x0, x1);
                        x0 = (x0 - mn) * rs * g0 + b0; x1 = (x1 - mn) * rs * g1 + b1;
                        GST16(ws + W_XV, RES_OFF(ai, bj, m), pack8(x0 * ALPHA + acc[ai][bj][m][0], x1 * ALPHA + acc[ai][bj][m][1]));
                    }
                    EPI_FENCE();
                }
            } else {
                LAS float* red = (LAS float*)(unsigned)LDS_RED;
                u32x4 buf[2][4]; float s1[4], s2[4];
#pragma unroll
                for (int m = 0; m < 4; ++m) buf[0][m] = GLD16(ws + W_XV, RES_OFF(0, 0, m));
#pragma unroll
                for (int bt = 0; bt < 4; ++bt) {
                    const int ai = bt >> 1, bj = bt & 1;
                    if (bt < 3) {
#pragma unroll
                        for (int m = 0; m < 4; ++m) buf[(bt + 1) & 1][m] = GLD16(ws + W_XV, RES_OFF((bt + 1) >> 1, (bt + 1) & 1, m));
                    }
                    EPI_FENCE();
#pragma unroll
                    for (int m = 0; m < 4; ++m) {
                        f32x4 x0, x1; unpack8(buf[bt & 1][m], x0, x1);
                        const u32x4 w = pack8(x0 * ALPHA + acc[ai][bj][m][0], x1 * ALPHA + acc[ai][bj][m][1]);
                        GST16(ws + W_XV, RES_OFF(ai, bj, m), w);
                        f32x4 r0, r1; unpack8(w, r0, r1);
                        const float a = ((r0[0] + r0[1]) + (r0[2] + r0[3])) + ((r1[0] + r1[1]) + (r1[2] + r1[3]));
                        const float b = ((r0[0] * r0[0] + r0[1] * r0[1]) + (r0[2] * r0[2] + r0[3] * r0[3])) + ((r1[0] * r1[0] + r1[1] * r1[1]) + (r1[2] * r1[2] + r1[3] * r1[3]));
                        if (bj == 0) { s1[m] = a; s2[m] = b; } else { s1[m] += a; s2[m] += b; }
                    }
                    if (bj == 1) {
#pragma unroll
                        for (int m = 0; m < 4; ++m) {
                            float a = s1[m], b = s2[m];
                            a = xsum32(xsum16(a)); b = xsum32(xsum16(b));
                            if (fq_ == 0) { const int ri = wc * 256 + ai * 128 + wr * 64 + m * 16 + fr_; red[2 * ri] = a; red[2 * ri + 1] = b; }
                        }
                    }
                    EPI_FENCE();
                }
                asm volatile("s_waitcnt lgkmcnt(0)" ::: "memory"); __builtin_amdgcn_s_barrier(); asm volatile("" ::: "memory");
                { int t3 = threadIdx.x; asm volatile("" : "+v"(t3));
                  if (t3 < 256) { float a = 0.f, b = 0.f;
#pragma unroll
                      for (int q = 0; q < 4; ++q) { a += red[2 * (q * 256 + t3)]; b += red[2 * (q * 256 + t3) + 1]; }
                      typedef float f32x2v __attribute__((ext_vector_type(2)));
                      *(f32x2v*)(ws + W_STA + ((unsigned)(u.pm * 256 + t3) * 4u + u.pn) * 8u) = (f32x2v){a, b}; } }
            }
#undef RES_OFF
        } else {
            EPI_COORDS();
            const bool smp = u.pm >= NTP;
            const int R0t = smp ? (MP + 248 * (u.pm - NTP) - 2) : (248 * u.pm - 2);
            const int lim = smp ? MT : MP;
            const float* cachef = Pq->in[I_CFF];
#pragma unroll
            for (int n = 0; n < 2; ++n) {
                EPI_FENCE();
                const unsigned f0 = 128 * u.pn + colw + 4 * n;
                const LAS f32x4* cwp = (const LAS f32x4*)(unsigned)(LDS_RED + par * 4096 + (8 * wc + 2 * fq_ + n) * 128);
                const f32x4 wg0 = cwp[0], wg1 = cwp[1], wg2 = cwp[2], wv0 = cwp[3], wv1 = cwp[4], wv2 = cwp[5], bg = cwp[6], bv = cwp[7];
#pragma unroll
                for (int ai = 0; ai < 2; ++ai) {
                    const int Rb = R0t + 62 * (2 * ai + wr);
#pragma unroll
                    for (int m = 0; m < 4; ++m) {
                        const int w = 16 * m + fr_, R = Rb + w;
                        const f32x4 g0 = acc[ai][0][m][n], v0 = acc[ai][1][m][n];
                        const f32x4 gp = acc[ai][0][m ? m - 1 : 0][n], vp = acc[ai][1][m ? m - 1 : 0][n];
                        f32x4 g1, g2, v1, v2;
#pragma unroll
                        for (int e = 0; e < 4; ++e) { g1[e] = shift1(g0[e], gp[e]); g2[e] = shift2(g0[e], gp[e]); v1[e] = shift1(v0[e], vp[e]); v2[e] = shift2(v0[e], vp[e]); }
                        const bool ok = (w >= 2) && (R < lim);
                        if (!smp) {
                            const int sq = R & 2047;
                            if (sq == 0) { g1 = (f32x4){0.f, 0.f, 0.f, 0.f}; v1 = g1; }
                            if (sq <= 1) { g2 = (f32x4){0.f, 0.f, 0.f, 0.f}; v2 = g2; }
                        } else if (ok) {
                            const int t = (R - MP) & 31, b = (R - MP) >> 5;
                            if (t <= 1) {
                                const float* c1 = cachef + ((size_t)(l * 16 + b) * 2 + 1) * 4096 + f0;
                                const f32x4 cg = *(const f32x4*)c1, cv = *(const f32x4*)(c1 + 2048);
                                if (t == 0) { g1 = cg; v1 = cv; g2 = *(const f32x4*)(c1 - 4096); v2 = *(const f32x4*)(c1 - 4096 + 2048); }
                                else { g2 = cg; v2 = cv; }
                            }
                        }
                        const f32x4 gg = wg0 * g2 + wg1 * g1 + wg2 * g0 + bg, vv = wv0 * v2 + wv1 * v1 + wv2 * v0 + bv;
                        f32x4 h;
#pragma unroll
                        for (int e = 0; e < 4; ++e) h[e] = gg[e] * sigmoidf_(gg[e]) * vv[e];
                        if (ok) {
                            u32x2 hw; hw.x = cvt_pk_bf16(h[0], h[1]); hw.y = cvt_pk_bf16(h[2], h[3]);
                            *(u32x2*)((unsigned char*)out + ((unsigned)R * 2048u + f0) * 2u) = hw;
                            if (!smp) {
                                const int sq = R & 2047;
                                if (sq >= 2046) { const unsigned o = (((l * 32 + (R >> 11)) * 2 + (sq - 2046)) * 4096 + f0) * 4; GSTF4(out + O_FFP, o, g0); GSTF4(out + O_FFP, o + 8192, v0); }
                            } else {
                                const int t = (R - MP) & 31, b = (R - MP) >> 5;
                                if (t >= 30) { const unsigned o = (((l * 16 + b) * 2 + (t - 30)) * 4096 + f0) * 4; GSTF4(out + O_FFS, o, g0); GSTF4(out + O_FFS, o + 8192, v0); }
                            }
                        }
                        EPI_FENCE();
                    }
                }
            }
        }
    }
};

struct Ctx { int tid, lane, wave, G, bid, gtid, NT, gw, NGW; };

__device__ __forceinline__ int ffperm(int n) { return n < 2048 ? ((n >> 7) << 8) + (n & 127) : (((n - 2048) >> 7) << 8) + 128 + ((n - 2048) & 127); }
__device__ __forceinline__ void transpose_item(const float* W, int K, int N, bf16_t* WT, LAS float* scr, int item, int lane, bool ffp = false, const float* gk = nullptr) {
    const int nblk = N / 32, kb = item / nblk, nb = item % nblk, k0 = 64 * kb, n0 = 32 * nb;
#pragma unroll 8
    for (int i = 0; i < 32; ++i) { const int kk = 2 * i + (lane >> 5); float wv = W[(size_t)(k0 + kk) * N + n0 + (lane & 31)]; if (gk) wv *= gk[k0 + kk]; scr[kk * 33 + (lane & 31)] = wv; }
    asm volatile("s_waitcnt lgkmcnt(0)" ::: "memory");
    const int c = lane & 7;
#pragma unroll
    for (int j = 0; j < 4; ++j) { const int n = (lane >> 3) + 8 * j; const LAS float* s = scr + (8 * c) * 33 + n;
        u32x4 o; o.x = cvt_pk_bf16(s[0 * 33], s[1 * 33]); o.y = cvt_pk_bf16(s[2 * 33], s[3 * 33]); o.z = cvt_pk_bf16(s[4 * 33], s[5 * 33]); o.w = cvt_pk_bf16(s[6 * 33], s[7 * 33]);
        const int nd = ffp ? ffperm(n0 + n) : (n0 + n);
        *(u32x4*)(WT + (size_t)nd * K + k0 + 8 * c) = o; }
    asm volatile("s_waitcnt lgkmcnt(0)" ::: "memory");
}

__device__ __forceinline__ void ln_in_load(const float* xrow, f32x4 (&v)[4], int lane) {
#pragma unroll
    for (int j = 0; j < 2; ++j) { v[2 * j] = *(const f32x4*)(xrow + lane * 8 + 512 * j); v[2 * j + 1] = *(const f32x4*)(xrow + lane * 8 + 512 * j + 4); }
}
__device__ __forceinline__ void ln_in_compute(f32x4 (&v)[4], const float* g, const float* b, bf16_t* orow, int lane) {
    float s = 0.f;
#pragma unroll
    for (int j = 0; j < 4; ++j) s += (v[j][0] + v[j][1]) + (v[j][2] + v[j][3]);
    const float mean = wave_sum(s) * (1.f / 1024.f); float q = 0.f;
#pragma unroll
    for (int j = 0; j < 4; ++j) { v[j] = v[j] - mean; q += (v[j][0] * v[j][0] + v[j][1] * v[j][1]) + (v[j][2] * v[j][2] + v[j][3] * v[j][3]); }
    const float rstd = 1.f / sqrtf(wave_sum(q) * (1.f / 1024.f) + LN_EPS);
#pragma unroll
    for (int j = 0; j < 2; ++j) {
        const int c = lane * 8 + 512 * j;
        const f32x4 g0 = *(const f32x4*)(g + c), g1 = *(const f32x4*)(g + c + 4), b0 = *(const f32x4*)(b + c), b1 = *(const f32x4*)(b + c + 4);
        *(u32x4*)(orow + c) = pack8(v[2 * j] * rstd * g0 + b0, v[2 * j + 1] * rstd * g1 + b1);
    }
}

__device__ __forceinline__ void ln_phase(const Ctx& C, unsigned char* ws, const float* g, const float* b, float* yout) {
    bf16_t* xv = (bf16_t*)(ws + W_XV);
    f32x4 gg[4], bb[4];
#pragma unroll
    for (int j = 0; j < 2; ++j) { const int c = C.lane * 8 + 512 * j; gg[2 * j] = *(const f32x4*)(g + c); gg[2 * j + 1] = *(const f32x4*)(g + c + 4); bb[2 * j] = *(const f32x4*)(b + c); bb[2 * j + 1] = *(const f32x4*)(b + c + 4); }
    for (int row0 = C.gw; row0 < MT; row0 += 4 * C.NGW) {
        u32x4 w[4][2];
#pragma unroll
        for (int k = 0; k < 4; ++k) { const int row = row0 + k * C.NGW;
            if (row < MT) {
#pragma unroll
                for (int j = 0; j < 2; ++j) w[k][j] = *(const u32x4*)(xv + (size_t)row * 1024 + C.lane * 8 + 512 * j);
            } else { w[k][0] = (u32x4){0u, 0u, 0u, 0u}; w[k][1] = w[k][0]; } }
#pragma unroll
        for (int k = 0; k < 4; ++k) { const int row = row0 + k * C.NGW;
            if (row < MT) {
                bf16_t* xr = xv + (size_t)row * 1024;
                f32x4 v[4]; float s = 0.f;
#pragma unroll
                for (int j = 0; j < 2; ++j) unpack8(w[k][j], v[2 * j], v[2 * j + 1]);
#pragma unroll
                for (int j = 0; j < 4; ++j) s += (v[j][0] + v[j][1]) + (v[j][2] + v[j][3]);
                const float mean = wave_sum(s) * (1.f / 1024.f); float q = 0.f;
#pragma unroll
                for (int j = 0; j < 4; ++j) { v[j] = v[j] - mean; q += (v[j][0] * v[j][0] + v[j][1] * v[j][1]) + (v[j][2] * v[j][2] + v[j][3] * v[j][3]); }
                const float rstd = 1.f / sqrtf(wave_sum(q) * (1.f / 1024.f) + LN_EPS);
#pragma unroll
                for (int j = 0; j < 4; ++j) v[j] = v[j] * rstd * gg[j] + bb[j];
#pragma unroll
                for (int j = 0; j < 2; ++j) *(u32x4*)(xr + C.lane * 8 + 512 * j) = pack8(v[2 * j], v[2 * j + 1]);
                if (yout) {
#pragma unroll
                    for (int j = 0; j < 2; ++j) { float* p = yout + (size_t)row * 1024 + C.lane * 8 + 512 * j; *(f32x4*)p = v[2 * j]; *(f32x4*)(p + 4) = v[2 * j + 1]; }
                }
            } }
    }
}

__device__ __forceinline__ void ssm_T_phase(const Ctx& C, int l, LAS unsigned char* lds) {
    const CParams Pp = get_params();
    LAS float* Wr = (LAS float*)lds; LAS float* Wi = Wr + 64 * 17;
    float* T = (float*)(Pp->ws + W_SSMT);
    for (int unit = C.bid; unit < 1024; unit += C.G) {
        const int g = unit >> 6, tau = unit & 63;
        const int p = C.tid >> 3, c2 = (C.tid & 7) * 2;
        const float lr = Pp->in[I_LAMRE][(l * 16 + g) * 64 + p], li = Pp->in[I_LAMIM][(l * 16 + g) * 64 + p], dt = __expf(Pp->in[I_LOGDT][l * 16 + g]);
        float er, ei, cr, ci; cpow_exp(lr, li, dt, (float)tau, er, ei); ssm_cf(lr, li, dt, cr, ci);
        const float fr_ = er * cr - ei * ci, fi_ = er * ci + ei * cr;
#pragma unroll
        for (int k = 0; k < 2; ++k) {
            const size_t bi = ((size_t)(l * 16 + g) * 64 + p) * 16 + c2 + k;
            const float br = Pp->in[I_BRE][bi], bim = Pp->in[I_BIM][bi];
            Wr[p * 17 + c2 + k] = fr_ * br - fi_ * bim; Wi[p * 17 + c2 + k] = fr_ * bim + fi_ * br;
        }
        __syncthreads();
        if (C.tid < 256) {
            const int co = C.tid >> 4, ci2 = C.tid & 15;
            const float* cre = Pp->in[I_CRE] + ((size_t)(l * 16 + g) * 16 + co) * 64; const float* cim = Pp->in[I_CIM] + ((size_t)(l * 16 + g) * 16 + co) * 64;
            float a = 0.f;
            for (int pp = 0; pp < 64; ++pp) a += cre[pp] * Wr[pp * 17 + ci2] - cim[pp] * Wi[pp * 17 + ci2];
            T[((size_t)(g * 64 + tau) * 16 + co) * 16 + ci2] = a;
        }
        __syncthreads();
    }
}

__device__ __forceinline__ void ssm_fill_phase(const Ctx& C, int l) {
    const CParams Pp = get_params();
    const float* T = (const float*)(Pp->ws + W_SSMT);
    bf16_t* YK = (bf16_t*)(Pp->ws + W_YK); bf16_t* HM = (bf16_t*)(Pp->ws + W_HM);
    for (int item = C.gtid; item < 16 * 1024 * 128; item += C.NT) {
        const int half = item & 1, s = (item >> 1) & 63, rowi = item >> 7, g = rowi >> 10, t = (rowi >> 4) & 63, co = rowi & 15;
        u32x4 w = (u32x4){0u, 0u, 0u, 0u};
        if (s <= t) { const float* tp = T + ((size_t)(g * 64 + (t - s)) * 16 + co) * 16 + half * 8; w = pack8(*(const f32x4*)tp, *(const f32x4*)(tp + 4)); }
        *(u32x4*)(YK + (size_t)rowi * 1152 + s * 16 + half * 8) = w;
    }
    for (int item = C.gtid; item < 16 * 1024 * 64; item += C.NT) {
        const int p = item & 63, rowi = item >> 6, g = rowi >> 10, t = (rowi >> 4) & 63, co = rowi & 15;
        const float lr = Pp->in[I_LAMRE][(l * 16 + g) * 64 + p], li = Pp->in[I_LAMIM][(l * 16 + g) * 64 + p], dt = __expf(Pp->in[I_LOGDT][l * 16 + g]);
        float er, ei; cpow_exp(lr, li, dt, (float)(t + 1), er, ei);
        const size_t ci_ = ((size_t)(l * 16 + g) * 16 + co) * 64 + p;
        const float cr = Pp->in[I_CRE][ci_], ci = Pp->in[I_CIM][ci_];
        YK[(size_t)rowi * 1152 + 1024 + p] = f2bf(cr * er - ci * ei);
        YK[(size_t)rowi * 1152 + 1088 + p] = f2bf(-(cr * ei + ci * er));
    }
    for (int item = C.gtid; item < 16 * 128 * 64; item += C.NT) {
        const int s = item & 63, pr = (item >> 6) & 127, g = item >> 13, p = pr & 63, part = pr >> 6;
        const float lr = Pp->in[I_LAMRE][(l * 16 + g) * 64 + p], li = Pp->in[I_LAMIM][(l * 16 + g) * 64 + p], dt = __expf(Pp->in[I_LOGDT][l * 16 + g]);
        float er, ei, cr, ci; cpow_exp(lr, li, dt, (float)(63 - s), er, ei); ssm_cf(lr, li, dt, cr, ci);
        const float fr_ = er * cr - ei * ci, fi_ = er * ci + ei * cr;
        const float* br = Pp->in[I_BRE] + ((size_t)(l * 16 + g) * 64 + p) * 16; const float* bi = Pp->in[I_BIM] + ((size_t)(l * 16 + g) * 64 + p) * 16;
        f32x4 o[4];
#pragma unroll
        for (int q = 0; q < 4; ++q) {
            const f32x4 b_r = *(const f32x4*)(br + 4 * q), b_i = *(const f32x4*)(bi + 4 * q);
            o[q] = part ? (b_i * fr_ + b_r * fi_) : (b_r * fr_ - b_i * fi_);
        }
        bf16_t* dst = HM + ((size_t)g * 256 + pr) * 1024 + s * 16;
        *(u32x4*)dst = pack8(o[0], o[1]); *(u32x4*)(dst + 8) = pack8(o[2], o[3]);
    }
    for (int item = C.gtid; item < 16 * 128 * 128; item += C.NT) {
        const int c8 = item & 127, r = (item >> 7) & 127, g = item >> 14;
        *(u32x4*)(HM + ((size_t)g * 256 + 128 + r) * 1024 + c8 * 8) = (u32x4){0u, 0u, 0u, 0u};
    }
}

__device__ __forceinline__ void convert_layer(const Ctx& C, LAS unsigned char* lds, int l, int part) {
    const CParams Pp = get_params();
    LAS float* scr = (LAS float*)(lds + C.wave * 16384);
    constexpr int I_A = 16 * 80, I_B = 16 * 32, I_C = 16 * 128, I_D = 32 * 32, I_E = 4 * 8, I_L = I_A + I_B + I_C + I_D + I_E;
    for (int it = C.gw; it < (part == 2 ? 0 : I_L); it += C.NGW) {
        int r = it;
        if (r < I_A) { transpose_item(Pp->in[I_WIN] + (size_t)l * DM * NPROJ, DM, NPROJ, (bf16_t*)(Pp->ws + W_WIN) + (size_t)l * NPROJ * DM, scr, r, C.lane, false, l ? Pp->in[I_LN2G] + (l - 1) * 1024 : nullptr); continue; } r -= I_A;
        if (r < I_B) { transpose_item(Pp->in[I_WOUT] + (size_t)l * DM * DM, DM, DM, (bf16_t*)(Pp->ws + W_WOUT) + (size_t)l * DM * DM, scr, r, C.lane); continue; } r -= I_B;
        if (r < I_C) { transpose_item(Pp->in[I_WFFI] + (size_t)l * DM * DFF2, DM, DFF2, (bf16_t*)(Pp->ws + W_WFFI) + (size_t)l * DFF2 * DM, scr, r, C.lane, true); continue; } r -= I_C;
        if (r < I_D) { transpose_item(Pp->in[I_WFFO] + (size_t)l * DFF * DM, DFF, DM, (bf16_t*)(Pp->ws + W_WFFO) + (size_t)l * DM * DFF, scr, r, C.lane); continue; } r -= I_D;
        transpose_item(Pp->in[I_WGLU] + (size_t)l * 65536, 256, 256, (bf16_t*)(Pp->ws + W_WGLU) + (size_t)l * 65536, scr, r, C.lane);
    }
    if (part == 1) return;
    for (int item = C.gtid; item < 16 * 512 * 8 * 8; item += C.NT) {
        const int d8 = item & 7, h = (item >> 3) & 7, j = (item >> 6) & 511, b = (item >> 15) & 15;
        const float* src = Pp->in[I_CK] + ((((size_t)(l * 16 + b) * 512 + j) * 8 + h) * 64 + d8 * 8);
        *(u32x4*)((bf16_t*)(Pp->ws + W_KS) + ((size_t)(l * 128 + b * 8 + h) * 544 + j) * 64 + d8 * 8) = pack8(*(const f32x4*)src, *(const f32x4*)(src + 4));
    }
    for (int item = C.gtid; item < 128 * 16 * 4 * 64; item += C.NT) {
        const int ln = item & 63, db = (item >> 6) & 3, st = (item >> 8) & 15, bh = (item >> 12) & 127;
        const int frv = ln & 15, fqv = ln >> 4, d = 16 * db + frv, b = bh >> 3, h = bh & 7;
        float v[8];
#pragma unroll
        for (int i = 0; i < 8; ++i) { const int key = 32 * st + (i < 4 ? 4 * fqv + i : 16 + 4 * fqv + i - 4);
            v[i] = Pp->in[I_CV][(((size_t)(l * 16 + b) * 512 + key) * 8 + h) * 64 + d]; }
        u32x4 w; w.x = cvt_pk_bf16(v[0], v[1]); w.y = cvt_pk_bf16(v[2], v[3]); w.z = cvt_pk_bf16(v[4], v[5]); w.w = cvt_pk_bf16(v[6], v[7]);
        *(u32x4*)((bf16_t*)(Pp->ws + W_VFS) + ((((size_t)(l * 128 + bh) * 18 + st) * 4 + db) * 64 + ln) * 8) = w;
    }
}

__device__ __forceinline__ void prologue_phase(const Ctx& C, LAS unsigned char* lds) {
    const CParams Pp = get_params();
    const int nconv = (C.G > 8) ? 1 : NL;
    for (int l = 0; l < nconv; ++l) convert_layer(C, lds, l, 0);
    for (int item = C.gtid; item < NL * 512 * 8; item += C.NT) {
        const int j = item & 7, grp = (item >> 3) & 511, l = item >> 12;
        const float* src = j < 3 ? Pp->in[I_FCW] + (size_t)(l * 3 + j) * 4096 + grp * 4 : j < 6 ? Pp->in[I_FCW] + (size_t)(l * 3 + j - 3) * 4096 + 2048 + grp * 4
                         : j == 6 ? Pp->in[I_FCB] + (size_t)l * 4096 + grp * 4 : Pp->in[I_FCB] + (size_t)l * 4096 + 2048 + grp * 4;
        *(f32x4*)(Pp->ws + W_CW + (size_t)item * 16) = *(const f32x4*)src;
    }
    for (int item = C.gtid; item < NL * 2560 * 16; item += C.NT) {
        const int n = item % 2560, kc = (item / 2560) & 15, l = item / (2560 * 16);
        const float* W = Pp->in[I_WIN] + (size_t)l * DM * NPROJ + (size_t)kc * 64 * NPROJ + n;
        const float* gk = Pp->in[I_LN2G] + (l ? l - 1 : 0) * 1024 + kc * 64;
        const float* bk = Pp->in[I_LN2B] + (l ? l - 1 : 0) * 1024 + kc * 64;
        float cs = 0.f, bs = 0.f;
#pragma unroll 16
        for (int k = 0; k < 64; ++k) { const float w = W[(size_t)k * NPROJ]; const float wf = l ? w * gk[k] : w; cs += bf1(f2bf(wf)); bs += l ? bk[k] * w : 0.f; }
        float* dst = (float*)(Pp->ws + W_CSP) + (size_t)item * 2;
        dst[0] = cs; dst[1] = bs;
    }
    for (int item = C.gtid; item < MT * 4; item += C.NT) { typedef float f32x2v __attribute__((ext_vector_type(2))); *(f32x2v*)(Pp->ws + W_STA + (size_t)item * 8) = (f32x2v){0.f, 256.f * (1.f - LN_EPS)}; }
    for (int item = C.gtid; item < 2048; item += C.NT) ((float*)(Pp->ws + W_ONE))[item] = item < 1024 ? 1.f : 0.f;
    for (int row0 = C.gw; row0 < MT; row0 += 3 * C.NGW) {
        f32x4 va[4], vb[4], vc[4];
        const int r1 = row0 + C.NGW, r2 = row0 + 2 * C.NGW;
        ln_in_load(row0 < MP ? Pp->in[I_XP] + (size_t)row0 * 1024 : Pp->in[I_XS] + (size_t)(row0 - MP) * 1024, va, C.lane);
        if (r1 < MT) ln_in_load(r1 < MP ? Pp->in[I_XP] + (size_t)r1 * 1024 : Pp->in[I_XS] + (size_t)(r1 - MP) * 1024, vb, C.lane);
        if (r2 < MT) ln_in_load(r2 < MP ? Pp->in[I_XP] + (size_t)r2 * 1024 : Pp->in[I_XS] + (size_t)(r2 - MP) * 1024, vc, C.lane);
        ln_in_compute(va, Pp->in[I_LNG], Pp->in[I_LNB], (bf16_t*)(Pp->ws + W_XV) + (size_t)row0 * 1024, C.lane);
        if (r1 < MT) ln_in_compute(vb, Pp->in[I_LNG], Pp->in[I_LNB], (bf16_t*)(Pp->ws + W_XV) + (size_t)r1 * 1024, C.lane);
        if (r2 < MT) ln_in_compute(vc, Pp->in[I_LNG], Pp->in[I_LNB], (bf16_t*)(Pp->ws + W_XV) + (size_t)r2 * 1024, C.lane);
    }
}

__device__ __forceinline__ void attn_unit(const bf16_t* __restrict__ Q, const bf16_t* __restrict__ K, const bf16_t* __restrict__ VFp,
                                          int nsteps, int dist0, const LAS float* bias, bf16_t* out, int nqb, int lane) {
    const int fr = lane & 15, fq = lane >> 4;
    bf16x8 qf[4][2];
#pragma unroll
    for (int qb = 0; qb < 4; ++qb)
#pragma unroll
        for (int ds = 0; ds < 2; ++ds) {
            if (qb < nqb) qf[qb][ds] = *(const bf16x8*)(Q + (size_t)(16 * qb + fr) * 64 + 32 * ds + 8 * fq);
            else qf[qb][ds] = (bf16x8){0, 0, 0, 0, 0, 0, 0, 0};
        }
    f32x4 o[4][4]; float mrow[4], lrow[4];
#pragma unroll
    for (int a = 0; a < 4; ++a) { mrow[a] = -1e30f; lrow[a] = 0.f;
#pragma unroll
        for (int b = 0; b < 4; ++b) o[a][b] = (f32x4){0.f, 0.f, 0.f, 0.f}; }
    bf16x8 kf[2][2];
    {
        const bf16_t* kp = K + (size_t)fr * 64 + 8 * fq;
#pragma unroll
        for (int kb = 0; kb < 2; ++kb)
#pragma unroll
            for (int ds = 0; ds < 2; ++ds) kf[kb][ds] = *(const bf16x8*)(kp + kb * 1024 + ds * 32);
    }
    const float bfar = bias[191];
    for (int st = 0; st < nsteps; ++st) {
        bf16x8 kn[2][2], vf[4];
        const bf16_t* vp = VFp + (size_t)st * 2048 + lane * 8;
#pragma unroll
        for (int db = 0; db < 4; ++db) vf[db] = *(const bf16x8*)(vp + db * 512);
        if (st + 1 < nsteps) {
            const bf16_t* kp = K + (size_t)(32 * (st + 1) + fr) * 64 + 8 * fq;
#pragma unroll
            for (int kb = 0; kb < 2; ++kb)
#pragma unroll
                for (int ds = 0; ds < 2; ++ds) kn[kb][ds] = *(const bf16x8*)(kp + kb * 1024 + ds * 32);
        } else {
#pragma unroll
            for (int kb = 0; kb < 2; ++kb)
#pragma unroll
                for (int ds = 0; ds < 2; ++ds) kn[kb][ds] = kf[kb][ds];
        }
        f32x4 s[2][4];
#pragma unroll
        for (int kb = 0; kb < 2; ++kb)
#pragma unroll
            for (int qb = 0; qb < 4; ++qb) {
                s[kb][qb] = __builtin_amdgcn_mfma_f32_16x16x32_bf16(kf[kb][0], qf[qb][0], (f32x4){0.f, 0.f, 0.f, 0.f}, 0, 0, 0);
                s[kb][qb] = __builtin_amdgcn_mfma_f32_16x16x32_bf16(kf[kb][1], qf[qb][1], s[kb][qb], 0, 0, 0);
            }
        const int dbase = dist0 + fr - 32 * st - 4 * fq;
        const bool far = (dist0 - 32 * st - 31) >= 128;
#pragma unroll
        for (int qb = 0; qb < 4; ++qb) {
            float mx = -1e30f;
            if (far) {
#pragma unroll
                for (int kb = 0; kb < 2; ++kb)
#pragma unroll
                    for (int r = 0; r < 4; ++r) { const float v = s[kb][qb][r] + bfar; s[kb][qb][r] = v; mx = fmaxf(mx, v); }
            } else {
#pragma unroll
                for (int kb = 0; kb < 2; ++kb)
#pragma unroll
                    for (int r = 0; r < 4; ++r) {
                        int d = dbase + 16 * qb - 16 * kb - r; d = d < -63 ? -63 : d; d = d > 128 ? 128 : d;
                        const float v = s[kb][qb][r] + bias[d + 63]; s[kb][qb][r] = v; mx = fmaxf(mx, v);
                    }
            }
            mx = xmax32(xmax16(mx));
            if (__any(mx > mrow[qb])) {
                const float mnew = fmaxf(mrow[qb], mx), al = fexp2(mrow[qb] - mnew); mrow[qb] = mnew; lrow[qb] *= al;
#pragma unroll
                for (int db = 0; db < 4; ++db) o[db][qb] = o[db][qb] * al;
            }
            const float mcur = mrow[qb];
            float ls = 0.f;
#pragma unroll
            for (int kb = 0; kb < 2; ++kb)
#pragma unroll
                for (int r = 0; r < 4; ++r) { const float p = fexp2(s[kb][qb][r] - mcur); s[kb][qb][r] = p; ls += p; }
            lrow[qb] += ls;
            u32x4 w; w.x = cvt_pk_bf16(s[0][qb][0], s[0][qb][1]); w.y = cvt_pk_bf16(s[0][qb][2], s[0][qb][3]); w.z = cvt_pk_bf16(s[1][qb][0], s[1][qb][1]); w.w = cvt_pk_bf16(s[1][qb][2], s[1][qb][3]);
            const bf16x8 pb = __builtin_bit_cast(bf16x8, w);
#pragma unroll
            for (int db = 0; db < 4; ++db) o[db][qb] = __builtin_amdgcn_mfma_f32_16x16x32_bf16(vf[db], pb, o[db][qb], 0, 0, 0);
        }
#pragma unroll
        for (int kb = 0; kb < 2; ++kb)
#pragma unroll
            for (int ds = 0; ds < 2; ++ds) kf[kb][ds] = kn[kb][ds];
    }
#pragma unroll
    for (int qb = 0; qb < 4; ++qb) {
        if (qb < nqb) {
            float lt = xsum32(xsum16(lrow[qb]));
            const float inv = 1.f / lt;
#pragma unroll
            for (int db = 0; db < 4; ++db) {
                const f32x4 v = o[db][qb] * inv; u32x2 w; w.x = cvt_pk_bf16(v[0], v[1]); w.y = cvt_pk_bf16(v[2], v[3]);
                *(u32x2*)(out + (size_t)(16 * qb + fr) * 1024 + 16 * db + 4 * fq) = w;
            }
        }
    }
}

__device__ __forceinline__ void sconv_phase(const Ctx& C, int l);
__device__ __forceinline__ void attn_phase(const Ctx& C, int l, LAS unsigned char* lds) {
    const CParams Pp = get_params();
    LAS float* bt = (LAS float*)lds;
    for (int i = C.tid; i < 8 * 192; i += 512) bt[i] = Pp->in[I_RELB][l * 1536 + i] * LOG2E;
    __syncthreads();
    const bf16_t* Qh = (const bf16_t*)(Pp->ws + W_QH); const bf16_t* Kh = (const bf16_t*)(Pp->ws + W_KH); const bf16_t* VF = (const bf16_t*)(Pp->ws + W_VF);
    bf16_t* mix = (bf16_t*)(Pp->ws + W_MIX);
    if (C.wave < 4) sconv_phase(C, l);
    for (int u = C.gw; u < 8192; u += C.NGW) {
        const int bh = u >> 5, c = ((u & 31) + 8 * (u >> 11)) & 31, b = bh >> 3, h = bh & 7;
        const int nkc = (c < 8 ? c : 8) + 1, m0 = b * 2048 + c * 64, k0 = m0 - (nkc - 1) * 64;
        attn_unit(Qh + ((size_t)h * MT + m0) * 64, Kh + ((size_t)h * MT + k0) * 64, VF + ((size_t)h * NCHK + (k0 >> 6)) * 4096,
                  2 * nkc, m0 - k0, bt + h * 192, mix + (size_t)m0 * 1024 + h * 64, 4, C.lane);
    }
    {
        const bool bal = (C.NGW == 2048);
        for (int us = bal ? (((C.gw & 15) == 0) ? (C.gw >> 4) : 128) : C.gw; us < 128; us += bal ? 128 : C.NGW) {
            const int b = us >> 3, h = us & 7;
            attn_unit(Qh + ((size_t)h * MT + MP + b * 32) * 64, (const bf16_t*)(Pp->ws + W_KS) + (size_t)(l * 128 + b * 8 + h) * 544 * 64,
                      (const bf16_t*)(Pp->ws + W_VFS) + (size_t)(l * 128 + b * 8 + h) * 18 * 2048, 17, 512, bt + h * 192,
                      mix + (size_t)(MP + b * 32) * 1024 + h * 64, 2, C.lane);
        }
    }
    if (C.wave >= 4) sconv_phase(C, l);
}

__device__ __forceinline__ void sconv_phase(const Ctx& C, int l) {
    const CParams Pp = get_params();
    const bf16_t* G = (const bf16_t*)(Pp->ws + W_G); bf16_t* mix = (bf16_t*)(Pp->ws + W_MIX);
    const int c = (C.gtid & 31) * 8;
    f32x4 w0[2], w1[2], w2[2], bs[2];
#pragma unroll
    for (int k = 0; k < 2; ++k) {
        w0[k] = *(const f32x4*)(Pp->in[I_SCW] + (size_t)(l * 3 + 0) * 256 + c + 4 * k); w1[k] = *(const f32x4*)(Pp->in[I_SCW] + (size_t)(l * 3 + 1) * 256 + c + 4 * k);
        w2[k] = *(const f32x4*)(Pp->in[I_SCW] + (size_t)(l * 3 + 2) * 256 + c + 4 * k); bs[k] = *(const f32x4*)(Pp->in[I_SCB] + (size_t)l * 256 + c + 4 * k);
    }
    for (int item = C.gtid; item < MT * 32; item += C.NT) {
        const int row = item >> 5;
        const bool smp = row >= MP; const int s = smp ? ((row - MP) & 31) : (row & 2047), b = smp ? ((row - MP) >> 5) : (row >> 11);
        const bf16_t* gr = G + (size_t)row * 768 + c;
        f32x4 gb0, gb1, a0, a1, x0, x1, i0[2], i1[2], i2[2];
        unpack8(*(const u32x4*)gr, gb0, gb1); unpack8(*(const u32x4*)(gr + 256), a0, a1); unpack8(*(const u32x4*)(gr + 512), x0, x1);
        i0[0] = a0 * x0; i0[1] = a1 * x1;
        if (s >= 1) { unpack8(*(const u32x4*)(gr - 768 + 256), a0, a1); unpack8(*(const u32x4*)(gr - 768 + 512), x0, x1); i1[0] = a0 * x0; i1[1] = a1 * x1; }
        else if (smp) { const float* cp = Pp->in[I_CSC] + ((size_t)(l * 16 + b) * 2 + 1) * 256 + c; i1[0] = *(const f32x4*)cp; i1[1] = *(const f32x4*)(cp + 4); }
        else { i1[0] = (f32x4){0.f, 0.f, 0.f, 0.f}; i1[1] = i1[0]; }
        if (s >= 2) { unpack8(*(const u32x4*)(gr - 2 * 768 + 256), a0, a1); unpack8(*(const u32x4*)(gr - 2 * 768 + 512), x0, x1); i2[0] = a0 * x0; i2[1] = a1 * x1; }
        else if (smp) { const float* cp = Pp->in[I_CSC] + ((size_t)(l * 16 + b) * 2 + s) * 256 + c; i2[0] = *(const f32x4*)cp; i2[1] = *(const f32x4*)(cp + 4); }
        else { i2[0] = (f32x4){0.f, 0.f, 0.f, 0.f}; i2[1] = i2[0]; }
        const f32x4 r0 = gb0 * (w0[0] * i2[0] + w1[0] * i1[0] + w2[0] * i0[0] + bs[0]);
        const f32x4 r1 = gb1 * (w0[1] * i2[1] + w1[1] * i1[1] + w2[1] * i0[1] + bs[1]);
        *(u32x4*)(mix + (size_t)row * 1024 + 768 + c) = pack8(r0, r1);
        if (!smp && s >= 2046) { float* p = Pp->out + O_SCP + ((size_t)(l * 32 + b) * 2 + (s - 2046)) * 256 + c; *(f32x4*)p = i0[0]; *(f32x4*)(p + 4) = i0[1]; }
        if (smp && s >= 30) { float* p = Pp->out + O_SCS + ((size_t)(l * 16 + b) * 2 + (s - 30)) * 256 + c; *(f32x4*)p = i0[0]; *(f32x4*)(p + 4) = i0[1]; }
    }
}

__device__ __forceinline__ void scan_phase(const Ctx& C, int l, LAS unsigned char* lds) {
    const CParams Pp = get_params();
    bf16_t* U2 = (bf16_t*)(Pp->ws + W_U2); const float* HL = (const float*)(Pp->ws + W_HLOC);
    {
        const int gw2 = C.wave * C.G + C.bid;
        for (int w = gw2; w < 512; w += C.NGW) {
            const int idx = w * 64 + C.lane, p = idx & 63, g = (idx >> 6) & 15, b = idx >> 10;
            const float lr = Pp->in[I_LAMRE][(l * 16 + g) * 64 + p], li = Pp->in[I_LAMIM][(l * 16 + g) * 64 + p], dt = __expf(Pp->in[I_LOGDT][l * 16 + g]);
            float ar, ai; cpow_exp(lr, li, dt, 64.f, ar, ai);
            float hr = 0.f, hi = 0.f;
#pragma unroll 8
            for (int c = 0; c < 32; ++c) {
                const size_t rowi = (size_t)g * 1024 + b * 32 + c;
                U2[rowi * 1152 + 1024 + p] = f2bf(hr); U2[rowi * 1152 + 1088 + p] = f2bf(hi);
                float xr = 0.f, xi = 0.f;
#pragma unroll
                for (int ks = 0; ks < 4; ++ks) { xr += HL[((size_t)ks * 16384 + rowi) * 128 + p]; xi += HL[((size_t)ks * 16384 + rowi) * 128 + 64 + p]; }
                const float nr = ar * hr - ai * hi + xr, ni = ar * hi + ai * hr + xi; hr = nr; hi = ni;
            }
            Pp->out[O_SRP + ((size_t)(l * 32 + b) * 16 + g) * 64 + p] = hr; Pp->out[O_SIP + ((size_t)(l * 32 + b) * 16 + g) * 64 + p] = hi;
        }
    }
    LAS float* us = (LAS float*)lds; LAS float* hsr = us + 512; LAS float* hsi = hsr + 32 * 65;
    const bf16_t* US = (const bf16_t*)(Pp->ws + W_US); bf16_t* Z = (bf16_t*)(Pp->ws + W_Z);
    for (int unit = C.bid; unit < 256; unit += C.G) {
        const int b = unit >> 4, g = unit & 15;
        { const int t = C.tid >> 4, c = C.tid & 15; us[C.tid] = bf1(US[(size_t)(b * 32 + t) * 256 + g * 16 + c]); }
        __syncthreads();
        if (C.tid < 64) {
            const int p = C.tid;
            const float lr = Pp->in[I_LAMRE][(l * 16 + g) * 64 + p], li = Pp->in[I_LAMIM][(l * 16 + g) * 64 + p], dt = __expf(Pp->in[I_LOGDT][l * 16 + g]);
            float ar, ai, cr, ci; cpow_exp(lr, li, dt, 1.f, ar, ai); ssm_cf(lr, li, dt, cr, ci);
            const float* br = Pp->in[I_BRE] + ((size_t)(l * 16 + g) * 64 + p) * 16; const float* bi = Pp->in[I_BIM] + ((size_t)(l * 16 + g) * 64 + p) * 16;
            f32x4 Br[4], Bi[4];
#pragma unroll
            for (int q = 0; q < 4; ++q) { const f32x4 b_r = *(const f32x4*)(br + 4 * q), b_i = *(const f32x4*)(bi + 4 * q); Br[q] = b_r * cr - b_i * ci; Bi[q] = b_i * cr + b_r * ci; }
            const size_t si = ((size_t)(l * 16 + b) * 16 + g) * 64 + p;
            float hr = Pp->in[I_SRE][si], hi = Pp->in[I_SIM][si];
            for (int t = 0; t < 32; ++t) {
                float bur = 0.f, bui = 0.f;
#pragma unroll
                for (int q = 0; q < 4; ++q)
#pragma unroll
                    for (int e = 0; e < 4; ++e) { const float uu = us[t * 16 + 4 * q + e]; bur += Br[q][e] * uu; bui += Bi[q][e] * uu; }
                const float nr = ar * hr - ai * hi + bur, ni = ar * hi + ai * hr + bui; hr = nr; hi = ni;
                hsr[t * 65 + p] = hr; hsi[t * 65 + p] = hi;
            }
            Pp->out[O_SRS + si] = hr; Pp->out[O_SIS + si] = hi;
        }
        __syncthreads();
        {
            const int t = C.tid >> 4, c = C.tid & 15;
            const float* cre = Pp->in[I_CRE] + ((size_t)(l * 16 + g) * 16 + c) * 64; const float* cim = Pp->in[I_CIM] + ((size_t)(l * 16 + g) * 16 + c) * 64;
            float y = 0.f;
            for (int p = 0; p < 64; ++p) y += cre[p] * hsr[t * 65 + p] - cim[p] * hsi[t * 65 + p];
            y += Pp->in[I_SD][l * 256 + g * 16 + c] * us[C.tid];
            Z[(size_t)(MP + b * 32 + t) * 256 + g * 16 + c] = f2bf(gelu_tanh(y));
        }
        __syncthreads();
    }
}


#define XB_TMO      128
#define XB_XCNT(j)  (256  + 64 * (j))
#define XB_XSUB(j)  (1280 + 64 * (j))
#define XB_XGEN(j)  (2304 + 64 * (j))
#define XB_TOP      3328
#define XB_TOPGEN   3392
#define XCD_BAR_WORDS 3456
#define XB_SPIN_CAP (1u << 18)
__device__ __forceinline__ unsigned xb_ld(unsigned* p)              { return __hip_atomic_load(p, __ATOMIC_RELAXED, __HIP_MEMORY_SCOPE_AGENT); }
__device__ __forceinline__ unsigned xb_add(unsigned* p, unsigned v) { return __hip_atomic_fetch_add(p, v, __ATOMIC_RELAXED, __HIP_MEMORY_SCOPE_AGENT); }
__device__ __forceinline__ unsigned xb_xcc_id() { return (unsigned)__builtin_amdgcn_s_getreg((3 << 11) | 20) & 0xFu; }
#define XB_SPIN(cond, bar) do { unsigned _sp = 0; while (cond) { __builtin_amdgcn_s_sleep(1); \
    if ((++_sp & 255u) == 0u) { if (xb_ld(&(bar)[XB_TMO])) break; if (_sp > XB_SPIN_CAP) { atomicAdd(&(bar)[XB_TMO], 1u); break; } } } } while (0)
struct XcdBarrier { unsigned* bar; unsigned x; volatile LAS unsigned* st; };
__device__ __forceinline__ void xcd_barrier_complete(unsigned* bar, unsigned x, unsigned& nloc, unsigned& nx) {
    const unsigned G = gridDim.x * gridDim.y * gridDim.z;
    unsigned sum, cnt, mine, sp = 0u;
    for (;;) {
        sum = 0u; cnt = 0u; mine = 0u;
#pragma unroll
        for (unsigned j = 0; j < 16; ++j) { const unsigned c = xb_ld(&bar[XB_XCNT(j)]); sum += c; cnt += (c > 0u) ? 1u : 0u; mine = (j == x) ? c : mine; }
        if (sum == G) break;
        __builtin_amdgcn_s_sleep(1);
        if ((++sp & 255u) == 0u) { if (xb_ld(&bar[XB_TMO])) break; if (sp > XB_SPIN_CAP) { atomicAdd(&bar[XB_TMO], 1u); break; } }
    }
    nloc = mine > 0u ? mine : 1u; nx = cnt > 0u ? cnt : 1u;
}
__device__ __forceinline__ void xcd_barrier(const XcdBarrier& b) {
    asm volatile("s_waitcnt vmcnt(0)" ::: "memory");
    __syncthreads();
    if (threadIdx.x == 0) {
        unsigned* bar = b.bar;
        __builtin_amdgcn_s_waitcnt(0);
        unsigned nloc = b.st[0], nx = b.st[1];
        if (nloc == 0u) { xcd_barrier_complete(bar, b.x, nloc, nx); b.st[0] = nloc; b.st[1] = nx; }
        const unsigned old = xb_add(&bar[XB_XSUB(b.x)], 1u);
        const unsigned gen = old / nloc;
        if (old + 1u == (gen + 1u) * nloc) {
            __builtin_amdgcn_fence(__ATOMIC_RELEASE, "agent");
            asm volatile("s_waitcnt vmcnt(0)" ::: "memory");
            const unsigned og = xb_add(&bar[XB_TOP], 1u);
            const unsigned tg = og / nx;
            if (og + 1u == (tg + 1u) * nx) xb_add(&bar[XB_TOPGEN], 1u);
            else XB_SPIN(xb_ld(&bar[XB_TOPGEN]) == tg, bar);
            __builtin_amdgcn_fence(__ATOMIC_ACQUIRE, "agent");
            xb_add(&bar[XB_XGEN(b.x)], 1u);
            asm volatile("s_waitcnt vmcnt(0)" ::: "memory");
        } else {
            XB_SPIN(xb_ld(&bar[XB_XGEN(b.x)]) == gen, bar);
            __builtin_amdgcn_fence(__ATOMIC_ACQUIRE, "agent");
            asm volatile("s_waitcnt vmcnt(0)" ::: "memory");
        }
    }
    __syncthreads();
}

enum { ST_PROJ = 0, ST_ATTN, ST_HLOC, ST_SCAN, ST_YSSM, ST_GLU, ST_OUT, ST_LN1, ST_FFIN, ST_FFOUT, ST_PER_LAYER };
constexpr int N_STEPS = 2 + NL * ST_PER_LAYER + 1;

__global__ void __launch_bounds__(512, 2) mega(Params P) {
    extern __shared__ __attribute__((aligned(16))) unsigned char lds_raw[];
    LAS unsigned char* lds = (LAS unsigned char*)lds_raw;
    const int step_lo = get_params()->lo, step_hi = get_params()->hi;
    volatile LAS unsigned* xst = (volatile LAS unsigned*)(lds + LDS_BYTES - 64);
    if (threadIdx.x == 0) { xst[0] = 0u; xst[1] = 0u; }
    __syncthreads();
    XcdBarrier xbar; xbar.bar = (unsigned*)(get_params()->ws + 4096); xbar.x = xb_xcc_id(); xbar.st = xst;
    if (step_hi - step_lo > 1 && threadIdx.x == 0) (void)xb_add(&xbar.bar[XB_XCNT(xbar.x)], 1u);
    for (int step = step_lo; step < step_hi; ++step) {
        bool sync_after = true;
        const CParams Pp = get_params();
        int tid_ = threadIdx.x, bid_ = blockIdx.x, G_ = gridDim.x; asm volatile("" : "+v"(tid_)); asm volatile("" : "+s"(bid_), "+s"(G_));
        Ctx C; C.tid = tid_; C.lane = tid_ & 63; C.wave = __builtin_amdgcn_readfirstlane(tid_ >> 6); C.G = G_; C.bid = bid_;
        C.gtid = bid_ * 512 + tid_; C.NT = G_ * 512; C.gw = bid_ * 8 + C.wave; C.NGW = G_ * 8;
        if (step == 0) { prologue_phase(C, lds); __syncthreads(); ssm_T_phase(C, 0, lds); }
        else if (step == 1) {
            ssm_fill_phase(C, 0);
            for (int item = C.gtid; item < NL * 2560; item += C.NT) {
                const int l = item / 2560, n = item % 2560; const float* src = (const float*)(Pp->ws + W_CSP) + ((size_t)l * 16 * 2560 + n) * 2;
                float cs = 0.f, bs = 0.f;
#pragma unroll
                for (int kc = 0; kc < 16; ++kc) { cs += src[(size_t)kc * 2560 * 2]; bs += src[(size_t)kc * 2560 * 2 + 1]; }
                float* dst = (float*)(Pp->ws + W_CS) + l * CS_L + n; dst[0] = cs; dst[2560] = bs;
            }
        }
        else if (step == N_STEPS - 1) { ln_phase(C, Pp->ws, Pp->in[I_LN2G] + (NL - 1) * 1024, Pp->in[I_LN2B] + (NL - 1) * 1024, Pp->out); }
        else {
            const int l = (step - 2) / ST_PER_LAYER, st = (step - 2) % ST_PER_LAYER;
            bool is_gemm = false; pg8::Gemm g; Epi E; E.l = l; E.mode = EM_PROJ; E.sub = 0;
            g.batch = 1; g.kshift = 0; g.ablk = 64; g.nM1 = 1 << 30; g.off2 = 0;
            switch (st) {
            case ST_PROJ: is_gemm = true; E.mode = EM_PROJ; g.A = (const bf16_t*)(Pp->ws + W_XV); g.Bt = (const bf16_t*)(Pp->ws + W_WIN) + (size_t)l * NPROJ * DM; g.M = MT; g.N = NPROJ; g.K = DM; g.lda = DM; g.ldb = DM; break;
            case ST_ATTN: attn_phase(C, l, lds); if (l + 1 < NL) { __syncthreads(); ssm_T_phase(C, l + 1, lds); } sync_after = false; break;
            case ST_HLOC: is_gemm = true; E.mode = EM_HLOC; g.A = (const bf16_t*)(Pp->ws + W_U2); g.Bt = (const bf16_t*)(Pp->ws + W_HM); g.M = 1024; g.N = 256; g.K = 256; g.lda = 1152; g.ldb = 1024; g.batch = 64; g.kshift = 2; break;
            case ST_SCAN: scan_phase(C, l, lds); break;
            case ST_YSSM: is_gemm = true; E.mode = EM_YSSM; g.A = (const bf16_t*)(Pp->ws + W_U2); g.Bt = (const bf16_t*)(Pp->ws + W_YK); g.M = 1024; g.N = 1024; g.K = 1152; g.lda = 1152; g.ldb = 1152; g.batch = 16; break;
            case ST_GLU: is_gemm = true; E.mode = EM_GLU; g.A = (const bf16_t*)(Pp->ws + W_Z); g.Bt = (const bf16_t*)(Pp->ws + W_WGLU) + (size_t)l * 65536; g.M = MT; g.N = 256; g.K = 256; g.lda = 256; g.ldb = 256; break;
            case ST_OUT: if (l + 1 < NL && C.bid >= 8 && C.G > 8) { Ctx C2 = C; C2.gtid = (C.bid - 8) * 512 + C.tid; C2.NT = (C.G - 8) * 512; ssm_fill_phase(C2, l + 1); }
                         else if (l + 1 < NL && C.G <= 8) ssm_fill_phase(C, l + 1);
                         is_gemm = true; E.mode = EM_RES; g.A = (const bf16_t*)(Pp->ws + W_MIX); g.Bt = (const bf16_t*)(Pp->ws + W_WOUT) + (size_t)l * DM * DM; g.M = MT; g.N = DM; g.K = DM; g.lda = DM; g.ldb = DM; break;
            case ST_LN1: ln_phase(C, Pp->ws, Pp->in[I_LN1G] + l * 1024, Pp->in[I_LN1B] + l * 1024, nullptr); break;
            case ST_FFIN: is_gemm = true; E.mode = EM_FFIN; g.A = (const bf16_t*)(Pp->ws + W_XV) - 2 * DM; g.Bt = (const bf16_t*)(Pp->ws + W_WFFI) + (size_t)l * DFF2 * DM; g.M = (NTP + NTS) * 256; g.N = DFF2; g.K = DM; g.lda = DM; g.ldb = DM; g.ablk = 62; g.nM1 = NTP; g.off2 = (unsigned)MP * DM * 2u; break;
            case ST_FFOUT: is_gemm = true; E.mode = EM_RES; E.sub = 1; g.A = (const bf16_t*)Pp->out; g.Bt = (const bf16_t*)(Pp->ws + W_WFFO) + (size_t)l * DM * DFF; g.M = MT; g.N = DM; g.K = DFF; g.lda = DFF; g.ldb = DFF; break;
            default: break;
            }
            if (is_gemm) { __syncthreads(); pg8::Order S; S.init(g.M, g.N, g.batch, C.G, (int)C.bid); S.rev = (st == ST_FFOUT || st == ST_OUT) ? 1 : 0; pg8::gemm_phase<Epi>(lds, g, S, E, C.tid); }
            if (st == ST_FFOUT && l + 1 < NL && C.G > 8 && C.bid >= 8) {
                Ctx C2 = C; C2.bid = C.bid - 8; C2.G = C.G - 8; C2.gtid = C2.bid * 512 + C.tid; C2.NT = C2.G * 512; C2.gw = C2.bid * 8 + C.wave; C2.NGW = C2.G * 8;
                convert_layer(C2, lds, l + 1, C.G > 192 ? 1 : 0);
            }
            if (st == ST_FFIN && l + 1 < NL && C.G > 192 && C.bid >= 192) {
                Ctx C2 = C; C2.bid = C.bid - 192; C2.G = C.G - 192; C2.gtid = C2.bid * 512 + C.tid; C2.NT = C2.G * 512; C2.gw = C2.bid * 8 + C.wave; C2.NGW = C2.G * 8;
                convert_layer(C2, lds, l + 1, 2);
            }
        }
        if (step + 1 < step_hi) {
            if (!sync_after) __syncthreads(); else if (step_hi == 0x7fffffff) cg::this_grid().sync(); else xcd_barrier(xbar);
        }
    }
}

extern "C" void kernel_launch(void* const* d_in, const int* in_sizes, int n_in, void* d_out, int out_size, void* d_ws, size_t ws_size, hipStream_t stream) {
    static int grid = 0;
    if (grid == 0) {
        if (n_in != 32 || (size_t)out_size != O_END || ws_size < W_END) { fprintf(stderr, "kernel_launch: unexpected sizes n_in=%d out=%d ws=%zu (need %zu)\n", n_in, out_size, ws_size, (size_t)W_END); grid = -1; return; }
        int dev = 0, cus = 0, per_cu = 0;
        hipGetDevice(&dev); hipDeviceGetAttribute(&cus, hipDeviceAttributeMultiprocessorCount, dev);
        hipFuncSetAttribute((const void*)mega, hipFuncAttributeMaxDynamicSharedMemorySize, LDS_BYTES);
        hipOccupancyMaxActiveBlocksPerMultiprocessor(&per_cu, (const void*)mega, 512, LDS_BYTES);
        if (per_cu < 1) { fprintf(stderr, "kernel_launch: occupancy query says %d blocks/CU\n", per_cu); per_cu = 1; }
        (void)hipGetLastError();
        grid = cus;
    }
    if (grid < 0) return;
    Params p{};
    for (int i = 0; i < 32; ++i) p.in[i] = (const float*)d_in[i];
    p.out = (float*)d_out; p.ws = (unsigned char*)d_ws;
#if SINGLE_LAUNCH
    hipMemsetAsync(d_ws, 0, 65536, stream);
    p.lo = 0; p.hi = N_STEPS;
    void* args[] = {&p};
    hipError_t e = hipLaunchCooperativeKernel((const void*)mega, dim3(grid), dim3(512), args, LDS_BYTES, stream);
    if (e != hipSuccess) fprintf(stderr, "cooperative launch failed: %s (grid %d)\n", hipGetErrorString(e), grid);
#else
#ifndef DBG_NSTEP
#define DBG_NSTEP N_STEPS
#endif
    for (int s = 0; s < DBG_NSTEP; ++s) {
        p.lo = s; p.hi = s + 1;
        hipLaunchKernelGGL(mega, dim3(grid), dim3(512), LDS_BYTES, stream, p);
    }
#ifdef DBG_DUMP
    hipMemcpyAsync(d_out, (unsigned char*)d_ws + DBG_DUMP, (size_t)500 * 1024 * 1024, hipMemcpyDeviceToDevice, stream);
#endif
#endif
}
```
